# Optimizing an MI355X kernel written in HIP

```python
import jax, jax.numpy as jnp
from jax import lax
import numpy as np

D_MODEL = 1024
BATCH = 2
SEQ = 8192
DEPTH = 2
DEC_BATCH = 16
DEC_SEQ = 2048
PAST_LEN = 128

HEAD_DIM = 64
GRID_W = 64
EPS = 1e-6
A_HEADS = 6
A_PATTERNS = ((128, 1), (512, 4), (2048, 16))
A_BLOCK = 64
ROPE_THETA = 500000.0
ROPE_DIMS = HEAD_DIM // 4
B_HEADS = 4
B_KV_HEADS = 2
B_QBLOCK = 128
AXIAL_THETA = 10000.0
C_HEADS = 6
NA_ROWS = 8
NA_COLS = 16

A_W = A_HEADS * HEAD_DIM
B_W = B_HEADS * HEAD_DIM
B_KV_W = B_KV_HEADS * HEAD_DIM
C_W = C_HEADS * HEAD_DIM
MIX_W = A_W + B_W + C_W
IN_W = 4 * A_W + 2 * B_W + 2 * B_KV_W + 4 * C_W

kernel_name = "hybrid_dilated_gqa_neighbourhood_encoder"


def _rmsnorm(x, g):
    xf = x.astype(jnp.float32)
    r = lax.rsqrt(jnp.mean(xf * xf, axis=-1, keepdims=True) + EPS)
    return (xf * r * g.astype(jnp.float32)).astype(x.dtype)


def _freqs(n_dims, theta):
    return theta ** (-jnp.arange(0, n_dims, 2, dtype=jnp.float32) / n_dims)


def _rotate(x, ang):
    n = ang.shape[-1]
    cos = jnp.cos(ang)[None, :, None, :].astype(x.dtype)
    sin = jnp.sin(ang)[None, :, None, :].astype(x.dtype)
    x1, x2 = x[..., :n], x[..., n:]
    return jnp.concatenate([x1 * cos - x2 * sin, x2 * cos + x1 * sin], axis=-1)


def _window_attn(q, k, v, radius):
    N, L, H, dh = q.shape
    nb = -(-L // A_BLOCK)
    Lp = nb * A_BLOCK
    nk = A_BLOCK + 2 * radius
    qb = jnp.pad(q, ((0, 0), (0, Lp - L), (0, 0), (0, 0))).reshape(N, nb, A_BLOCK, H, dh)
    pad = ((0, 0), (radius, Lp - L + radius), (0, 0), (0, 0))
    kidx = (jnp.arange(nb) * A_BLOCK)[:, None] + jnp.arange(nk)[None, :]
    kb = jnp.pad(k, pad)[:, kidx]
    vb = jnp.pad(v, pad)[:, kidx]
    qpos = (jnp.arange(nb) * A_BLOCK)[:, None] + jnp.arange(A_BLOCK)[None, :]
    kpos = (kidx - radius)[:, None, :]
    valid = (jnp.abs(kpos - qpos[:, :, None]) <= radius) & (kpos >= 0) & (kpos < L)
    s = jnp.einsum('nbqhd,nbkhd->nbhqk', qb, kb).astype(jnp.float32) * (dh ** -0.5)
    s = jnp.where(valid[None, :, None], s, -jnp.inf)
    m = jnp.max(s, axis=-1, keepdims=True)
    p = jnp.exp(s - m)
    l = jnp.sum(p, axis=-1, keepdims=True)
    o = jnp.einsum('nbhqk,nbkhd->nbqhd', (p / l).astype(v.dtype), vb)
    lse = (m + jnp.log(l))[..., 0]
    o = o.reshape(N, Lp, H, dh)[:, :L]
    lse = lse.transpose(0, 1, 3, 2).reshape(N, Lp, H)[:, :L]
    return o, lse


def _to_residues(t, dil):
    B, S, H, dh = t.shape
    return t.reshape(B, S // dil, dil, H, dh).transpose(0, 2, 1, 3, 4).reshape(B * dil, S // dil, H, dh)


def _from_residues(t, B, dil):
    N, L = t.shape[0], t.shape[1]
    rest = t.shape[2:]
    t = t.reshape((B, dil, L) + rest)
    t = jnp.swapaxes(t, 1, 2)
    return t.reshape((B, L * dil) + rest)


def _dilated_attention(q, k, v):
    B, S, H, dh = q.shape
    outs, lses = [], []
    for window, dil in A_PATTERNS:
        radius = window // (2 * dil)
        o, lse = _window_attn(_to_residues(q, dil), _to_residues(k, dil), _to_residues(v, dil), radius)
        outs.append(_from_residues(o, B, dil))
        lses.append(_from_residues(lse, B, dil))
    w = jax.nn.softmax(jnp.stack(lses, axis=-1), axis=-1)
    out = sum(w[..., i, None].astype(q.dtype) * outs[i] for i in range(len(A_PATTERNS)))
    return out.reshape(B, S, H * dh)


def _gqa_axial(q, k, v, q_norm, k_norm):
    B, S, Hq, dh = q.shape
    q = _rmsnorm(q, q_norm)
    k = _rmsnorm(k, k_norm)
    t = jnp.arange(S)
    f = _freqs(dh // 2, AXIAL_THETA)
    ang_row = (t // GRID_W).astype(jnp.float32)[:, None] * f
    ang_col = (t % GRID_W).astype(jnp.float32)[:, None] * f
    half = dh // 2
    q = jnp.concatenate([_rotate(q[..., :half], ang_row), _rotate(q[..., half:], ang_col)], axis=-1)
    k = jnp.concatenate([_rotate(k[..., :half], ang_row), _rotate(k[..., half:], ang_col)], axis=-1)
    rep = Hq // B_KV_HEADS
    nqb = S // B_QBLOCK
    qb = q.reshape(B, nqb, B_QBLOCK, B_KV_HEADS, rep, dh).transpose(1, 0, 2, 3, 4, 5)
    scale = dh ** -0.5

    def block(qi):
        s = jnp.einsum('bqgrd,bkgd->bgrqk', qi, k).astype(jnp.float32) * scale
        p = jax.nn.softmax(s, axis=-1).astype(v.dtype)
        return jnp.einsum('bgrqk,bkgd->bqgrd', p, v)

    o = lax.map(block, qb)
    return o.transpose(1, 0, 2, 3, 4, 5).reshape(B, S, Hq * dh)


def _neighbourhood_attn(q, k, v, rel_bias):
    B, S, H, dh = q.shape
    R = S // GRID_W
    kh = min(NA_ROWS, R)
    rows = jnp.arange(R)
    rs = jnp.clip(rows - NA_ROWS // 2, 0, R - kh)
    krow = rs[:, None] + jnp.arange(kh)[None, :]
    cols = jnp.arange(GRID_W)
    cs = jnp.clip(cols - NA_COLS // 2, 0, GRID_W - NA_COLS)
    col_valid = (cols[None, :] >= cs[:, None]) & (cols[None, :] < cs[:, None] + NA_COLS)
    qg = q.reshape(B, R, GRID_W, H, dh)
    kg = k.reshape(B, R, GRID_W, H, dh)[:, krow]
    vg = v.reshape(B, R, GRID_W, H, dh)[:, krow]
    s = jnp.einsum('brqhd,brikhd->brhqik', qg, kg).astype(jnp.float32) * (dh ** -0.5)
    ro = krow - rows[:, None] + (NA_ROWS - 1)
    co = jnp.clip(cols[None, :] - cols[:, None] + (NA_COLS - 1), 0, 2 * NA_COLS - 2)
    bias = rel_bias[:, ro[:, None, :, None], co[None, :, None, :]]
    s = s + bias.transpose(1, 0, 2, 3, 4)[None].astype(jnp.float32)
    s = jnp.where(col_valid[:, None, :], s, -jnp.inf)
    p = jax.nn.softmax(s.reshape(s.shape[:4] + (kh * GRID_W,)), axis=-1)
    p = p.reshape(s.shape).astype(v.dtype)
    o = jnp.einsum('brhqik,brikhd->brqhd', p, vg)
    return o.reshape(B, S, H * dh)


def _layer(x, norm_pre, w_in, q_norm, k_norm, rel_bias, branch_gain, w_out, norm_post):
    B, S, _ = x.shape
    h = _rmsnorm(x, norm_pre)
    proj = h @ w_in
    widths = [A_W] * 4 + [B_W, B_KV_W, B_KV_W, B_W] + [C_W] * 4
    cuts = [int(c) for c in np.cumsum(widths)[:-1]]
    aq, ak, av, az, bq, bk, bv, bz, cq, ck, cv, cz = jnp.split(proj, cuts, axis=-1)
    heads = lambda t: t.reshape(B, S, t.shape[-1] // HEAD_DIM, HEAD_DIM)

    ang = jnp.arange(S, dtype=jnp.float32)[:, None] * _freqs(ROPE_DIMS, ROPE_THETA)
    aq, ak = heads(aq), heads(ak)
    aq = jnp.concatenate([_rotate(aq[..., :ROPE_DIMS], ang), aq[..., ROPE_DIMS:]], axis=-1)
    ak = jnp.concatenate([_rotate(ak[..., :ROPE_DIMS], ang), ak[..., ROPE_DIMS:]], axis=-1)
    ya = _dilated_attention(aq, ak, heads(av))
    yb = _gqa_axial(heads(bq), heads(bk), heads(bv), q_norm, k_norm)
    yc = _neighbourhood_attn(heads(cq), heads(ck), heads(cv), rel_bias)

    ga, gb, gc = jnp.split(branch_gain, [A_W, A_W + B_W])
    y = jnp.concatenate([
        _rmsnorm(ya * jax.nn.silu(az), ga),
        _rmsnorm(yb * jax.nn.silu(bz), gb),
        _rmsnorm(yc * jax.nn.silu(cz), gc),
    ], axis=-1)
    return x + _rmsnorm(y @ w_out, norm_post)


def setup_inputs(seed: int = 0) -> dict:
    key = jax.random.key(seed)
    ks = jax.random.split(key, 10)
    f32 = jnp.float32
    nrm = jax.random.normal
    return {
        "x_prompt": nrm(ks[0], (BATCH, SEQ, D_MODEL), f32),
        "x_sample": nrm(ks[1], (DEC_BATCH, DEC_SEQ, D_MODEL), f32),
        "norm_pre": 1.0 + 0.05 * nrm(ks[2], (DEPTH, D_MODEL), f32),
        "w_in": nrm(ks[3], (DEPTH, D_MODEL, IN_W), f32) * (D_MODEL ** -0.5),
        "q_norm": 1.0 + 0.05 * nrm(ks[4], (DEPTH, HEAD_DIM), f32),
        "k_norm": 1.0 + 0.05 * nrm(ks[5], (DEPTH, HEAD_DIM), f32),
        "rel_bias": 0.1 * nrm(ks[6], (DEPTH, C_HEADS, 2 * NA_ROWS - 1, 2 * NA_COLS - 1), f32),
        "branch_gain": 1.0 + 0.05 * nrm(ks[7], (DEPTH, MIX_W), f32),
        "w_out": nrm(ks[8], (DEPTH, MIX_W, D_MODEL), f32) * (MIX_W ** -0.5),
        "norm_post": 1.0 + 0.05 * nrm(ks[9], (DEPTH, D_MODEL), f32),
    }


def reference(x_prompt, x_sample, norm_pre, w_in, q_norm, k_norm, rel_bias, branch_gain, w_out, norm_post):
    y_prompt = x_prompt
    y_sample = x_sample
    for l in range(DEPTH):
        params = (norm_pre[l], w_in[l], q_norm[l], k_norm[l], rel_bias[l], branch_gain[l], w_out[l], norm_post[l])
        y_prompt = _layer(y_prompt, *params)
        y_sample = _layer(y_sample, *params)
    return (y_prompt, y_sample)
```

```cpp
#include <hip/hip_runtime.h>
#include <stdint.h>

namespace nv {
constexpr int DM = 1024, NTOK = 49152, NPROW = 16384, SEQP = 8192, SEQS = 2048, INW = 3840;
constexpr float EPS = 1e-6f;
typedef unsigned short bf16_t;
__device__ __forceinline__ bf16_t f2bf(float f) { unsigned u = __float_as_uint(f); u += 0x7fffu + ((u >> 16) & 1u); return (bf16_t)(u >> 16); }
__device__ __forceinline__ float bf2f(bf16_t b) { return __uint_as_float(((unsigned)b) << 16); }
__device__ __forceinline__ void row_info(int row, int& base, int& S, int& t) {
    if (row < NPROW) { S = SEQP; base = row & ~(SEQP - 1); t = row & (SEQP - 1); }
    else { S = SEQS; const int r = row - NPROW; base = NPROW + (r & ~(SEQS - 1)); t = r & (SEQS - 1); }
}
constexpr size_t WS_PROJ = 0;
constexpr size_t WS_U = WS_PROJ + (size_t)NTOK * INW * 2;
constexpr size_t WS_SSQ = WS_U + (size_t)NTOK * DM * 2;
constexpr size_t WS_SSQ2 = WS_SSQ + (size_t)NTOK * 16 * 4;
constexpr size_t WS_RPRE = WS_SSQ2 + (size_t)NTOK * 16 * 4;
constexpr size_t WS_TABA = WS_RPRE + (size_t)NTOK * 4;
constexpr size_t WS_TABR = WS_TABA + (size_t)8192 * 16 * 4;
constexpr size_t WS_TABC = WS_TABR + (size_t)128 * 32 * 4;
constexpr size_t WS_END = WS_TABC + (size_t)64 * 32 * 4;

__global__ void k_tables(float* tabA, float* tabR, float* tabC) {
    const int i = blockIdx.x * blockDim.x + threadIdx.x;
    if (i < 8192 * 8) { const int t = i >> 3, j = i & 7; const double f = pow(500000.0, -(double)j / 8.0); const double a = (double)t * f; tabA[t * 16 + j] = (float)cos(a); tabA[t * 16 + 8 + j] = (float)sin(a); }
    if (i < 128 * 16) { const int t = i >> 4, j = i & 15; const double f = pow(10000.0, -(double)j / 16.0); const double a = (double)t * f; tabR[t * 32 + j] = (float)cos(a); tabR[t * 32 + 16 + j] = (float)sin(a); }
    if (i < 64 * 16) { const int t = i >> 4, j = i & 15; const double f = pow(10000.0, -(double)j / 16.0); const double a = (double)t * f; tabC[t * 32 + j] = (float)cos(a); tabC[t * 32 + 16 + j] = (float)sin(a); }
}
__global__ void k_prep(const float* xp, const float* xs, bf16_t* xb, float* rpre) {
    const int row = blockIdx.x, tid = threadIdx.x;
    const float* x = row < NPROW ? xp + (size_t)row * DM : xs + (size_t)(row - NPROW) * DM;
    const float4 v = ((const float4*)x)[tid];
    float s = v.x * v.x + v.y * v.y + v.z * v.z + v.w * v.w;
    __shared__ float red[4];
    for (int o = 32; o; o >>= 1) s += __shfl_xor(s, o);
    if ((tid & 63) == 0) red[tid >> 6] = s;
    __syncthreads();
    s = red[0] + red[1] + red[2] + red[3];
    if (tid == 0) rpre[row] = rsqrtf(s / DM + EPS);
    ushort4 o; o.x = f2bf(v.x); o.y = f2bf(v.y); o.z = f2bf(v.z); o.w = f2bf(v.w);
    ((ushort4*)(xb + (size_t)row * DM))[tid] = o;
}
__global__ void __launch_bounds__(256) k_inproj(const bf16_t* xb, const float* rpre, const float* W  , const float* gpre, const float* qn, const float* kn,
                                                const float* tabA, const float* tabR, const float* tabC, bf16_t* proj) {
    __shared__ float As[16][68], Bs[16][68], Ct[64][65];
    const int tid = threadIdx.x, tx = tid & 15, ty = tid >> 4, row0 = blockIdx.x * 64, hidx = blockIdx.y, n0 = hidx * 64;
    float acc[4][4] = {};
    for (int k0 = 0; k0 < DM; k0 += 16) {
        { const int r = tid >> 2, kk = (tid & 3) * 4; const ushort4 a = *(const ushort4*)(xb + (size_t)(row0 + r) * DM + k0 + kk);
          As[kk][r] = bf2f(a.x); As[kk + 1][r] = bf2f(a.y); As[kk + 2][r] = bf2f(a.z); As[kk + 3][r] = bf2f(a.w); }
        { const int kr = tid >> 4, c = (tid & 15) * 4; const float4 b = *(const float4*)(W + (size_t)(k0 + kr) * INW + n0 + c); const float g = gpre[k0 + kr];
          Bs[kr][c] = b.x * g; Bs[kr][c + 1] = b.y * g; Bs[kr][c + 2] = b.z * g; Bs[kr][c + 3] = b.w * g; }
        __syncthreads();
#pragma unroll
        for (int kk = 0; kk < 16; ++kk) {
            float a[4], b[4];
#pragma unroll
            for (int i = 0; i < 4; ++i) { a[i] = As[kk][ty * 4 + i]; b[i] = Bs[kk][tx * 4 + i]; }
#pragma unroll
            for (int i = 0; i < 4; ++i)
#pragma unroll
                for (int j = 0; j < 4; ++j) acc[i][j] += a[i] * b[j];
        }
        __syncthreads();
    }
#pragma unroll
    for (int i = 0; i < 4; ++i) { const float r = rpre[row0 + ty * 4 + i];
#pragma unroll
        for (int j = 0; j < 4; ++j) Ct[ty * 4 + i][tx * 4 + j] = acc[i][j] * r; }
    __syncthreads();
    if (tid < 64) {
        const int row = row0 + tid; int base, S, t; row_info(row, base, S, t);
        float v[64];
#pragma unroll
        for (int d = 0; d < 64; ++d) v[d] = Ct[tid][d];
        if (hidx < 12) {
            const float* tb = tabA + t * 16;
#pragma unroll
            for (int j = 0; j < 8; ++j) { const float c = tb[j], s = tb[8 + j], x1 = v[j], x2 = v[8 + j]; v[j] = x1 * c - x2 * s; v[8 + j] = x2 * c + x1 * s; }
        } else if (hidx >= 24 && hidx < 30) {
            const float* g = hidx < 28 ? qn : kn;
            float s = 0.f;
#pragma unroll
            for (int d = 0; d < 64; ++d) s += v[d] * v[d];
            const float r = rsqrtf(s / 64.f + EPS);
#pragma unroll
            for (int d = 0; d < 64; ++d) v[d] = v[d] * r * g[d];
            const float* tr = tabR + (t >> 6) * 32; const float* tc = tabC + (t & 63) * 32;
#pragma unroll
            for (int j = 0; j < 16; ++j) { float c = tr[j], sn = tr[16 + j], x1 = v[j], x2 = v[16 + j]; v[j] = x1 * c - x2 * sn; v[16 + j] = x2 * c + x1 * sn;
                c = tc[j]; sn = tc[16 + j]; x1 = v[32 + j]; x2 = v[48 + j]; v[32 + j] = x1 * c - x2 * sn; v[48 + j] = x2 * c + x1 * sn; }
        }
        bf16_t* o = proj + (size_t)row * INW + n0;
#pragma unroll
        for (int d = 0; d < 64; d += 4) { ushort4 w; w.x = f2bf(v[d]); w.y = f2bf(v[d + 1]); w.z = f2bf(v[d + 2]); w.w = f2bf(v[d + 3]); *(ushort4*)(o + d) = w; }
    }
}
__device__ __forceinline__ float silu(float z) { return z / (1.f + __expf(-z)); }
__global__ void __launch_bounds__(256) k_attnB(bf16_t* proj, float* ssq) {
    __shared__ float Ks[64][64], Vs[64][64];
    const int tid = threadIdx.x, h = blockIdx.y, kvh = h >> 1;
    int qb = blockIdx.x, base, S;
    if (qb < 64) { base = (qb >> 5) * SEQP; S = SEQP; qb &= 31; } else { qb -= 64; base = NPROW + (qb >> 3) * SEQS; S = SEQS; qb &= 7; }
    const int row = base + qb * 256 + tid;
    bf16_t* qp = proj + (size_t)row * INW + 1536 + h * 64;
    float q[64], o[64];
#pragma unroll
    for (int d = 0; d < 64; ++d) { q[d] = bf2f(qp[d]) * 0.125f; o[d] = 0.f; }
    float m = -1e30f, l = 0.f;
    for (int kt = 0; kt < S; kt += 64) {
        { const int r = tid >> 2, d0 = (tid & 3) * 16; const bf16_t* kp = proj + (size_t)(base + kt + r) * INW + 1792 + kvh * 64 + d0; const bf16_t* vp = proj + (size_t)(base + kt + r) * INW + 1920 + kvh * 64 + d0;
#pragma unroll
          for (int i = 0; i < 16; ++i) { Ks[r][d0 + i] = bf2f(kp[i]); Vs[r][d0 + i] = bf2f(vp[i]); } }
        __syncthreads();
        for (int j0 = 0; j0 < 64; j0 += 8) {
            float s[8]; float cm = -1e30f;
#pragma unroll
            for (int j = 0; j < 8; ++j) { float a = 0.f;
#pragma unroll
                for (int d = 0; d < 64; ++d) a += q[d] * Ks[j0 + j][d];
                s[j] = a; cm = fmaxf(cm, a); }
            const float mn = fmaxf(m, cm), corr = __expf(m - mn); m = mn; l *= corr;
#pragma unroll
            for (int d = 0; d < 64; ++d) o[d] *= corr;
#pragma unroll
            for (int j = 0; j < 8; ++j) { const float p = __expf(s[j] - mn); l += p;
#pragma unroll
                for (int d = 0; d < 64; ++d) o[d] += p * Vs[j0 + j][d]; }
        }
        __syncthreads();
    }
    const float il = 1.f / l; const bf16_t* zp = proj + (size_t)row * INW + 2048 + h * 64; float sq = 0.f;
#pragma unroll
    for (int d = 0; d < 64; ++d) { const float y = o[d] * il * silu(bf2f(zp[d])); const bf16_t yb = f2bf(y); const float yr = bf2f(yb); sq += yr * yr; qp[d] = yb; }
    ssq[(size_t)row * 16 + 6 + h] = sq;
}
__global__ void __launch_bounds__(256) k_attnA(bf16_t* proj, float* ssq) {
    const int row = blockIdx.x * 256 + threadIdx.x, h = blockIdx.y; int base, S, t; row_info(row, base, S, t);
    bf16_t* qp = proj + (size_t)row * INW + h * 64;
    float q[64], o[64];
#pragma unroll
    for (int d = 0; d < 64; ++d) { q[d] = bf2f(qp[d]) * 0.125f; o[d] = 0.f; }
    float m = -1e30f, l = 0.f;
    for (int p = 0; p < 3; ++p) { const int dil = p == 0 ? 1 : (p == 1 ? 4 : 16);
        for (int dlt = -64; dlt <= 64; ++dlt) { const int tk = t + dlt * dil; if (tk < 0 || tk >= S) continue;
            const bf16_t* kp = proj + (size_t)(base + tk) * INW + 384 + h * 64; const bf16_t* vp = kp + 384;
            float s = 0.f;
#pragma unroll
            for (int d = 0; d < 64; ++d) s += q[d] * bf2f(kp[d]);
            const float mn = fmaxf(m, s), corr = __expf(m - mn), pr = __expf(s - mn); m = mn; l = l * corr + pr;
#pragma unroll
            for (int d = 0; d < 64; ++d) o[d] = o[d] * corr + pr * bf2f(vp[d]); } }
    const float il = 1.f / l; const bf16_t* zp = proj + (size_t)row * INW + 1152 + h * 64; float sq = 0.f;
    bf16_t* yp = qp;
#pragma unroll
    for (int d = 0; d < 64; ++d) { const float y = o[d] * il * silu(bf2f(zp[d])); const bf16_t yb = f2bf(y); const float yr = bf2f(yb); sq += yr * yr; yp[d] = yb; }
    ssq[(size_t)row * 16 + h] = sq;
}
__global__ void __launch_bounds__(256) k_attnC(bf16_t* proj, const float* relb  , float* ssq) {
    const int row = blockIdx.x * 256 + threadIdx.x, h = blockIdx.y; int base, S, t; row_info(row, base, S, t);
    const int R = S >> 6, gr = t >> 6, gc = t & 63;
    int rs = gr - 4; rs = rs < 0 ? 0 : (rs > R - 8 ? R - 8 : rs);
    int cs = gc - 8; cs = cs < 0 ? 0 : (cs > 48 ? 48 : cs);
    bf16_t* qp = proj + (size_t)row * INW + 2304 + h * 64;
    float q[64], o[64];
#pragma unroll
    for (int d = 0; d < 64; ++d) { q[d] = bf2f(qp[d]) * 0.125f; o[d] = 0.f; }
    float m = -1e30f, l = 0.f;
    for (int i = 0; i < 8; ++i) { const int kr = rs + i, ro = kr - gr + 7;
        for (int j = 0; j < 16; ++j) { const int kc = cs + j; int co = kc - gc + 15; co = co < 0 ? 0 : (co > 30 ? 30 : co);
            const int tk = kr * 64 + kc;
            const bf16_t* kp = proj + (size_t)(base + tk) * INW + 2688 + h * 64; const bf16_t* vp = kp + 384;
            float s = relb[(h * 15 + ro) * 31 + co];
#pragma unroll
            for (int d = 0; d < 64; ++d) s += q[d] * bf2f(kp[d]);
            const float mn = fmaxf(m, s), corr = __expf(m - mn), pr = __expf(s - mn); m = mn; l = l * corr + pr;
#pragma unroll
            for (int d = 0; d < 64; ++d) o[d] = o[d] * corr + pr * bf2f(vp[d]); } }
    const float il = 1.f / l; const bf16_t* zp = proj + (size_t)row * INW + 3456 + h * 64; float sq = 0.f;
#pragma unroll
    for (int d = 0; d < 64; ++d) { const float y = o[d] * il * silu(bf2f(zp[d])); const bf16_t yb = f2bf(y); const float yr = bf2f(yb); sq += yr * yr; qp[d] = yb; }
    ssq[(size_t)row * 16 + 10 + h] = sq;
}
__device__ __forceinline__ int colmap(int k) { return k < 384 ? k : (k < 640 ? 1536 + (k - 384) : 2304 + (k - 640)); }
__global__ void __launch_bounds__(256) k_outproj(const bf16_t* proj, const float* ssq, const float* W  , const float* gain, bf16_t* raw, float* ssq2) {
    __shared__ float As[16][68], Bs[16][68], rb[64][3], red[64][17];
    const int tid = threadIdx.x, tx = tid & 15, ty = tid >> 4, row0 = blockIdx.x * 64, n0 = blockIdx.y * 64;
    if (tid < 64) { const float* s = ssq + (size_t)(row0 + tid) * 16; float a = 0.f, b = 0.f, c = 0.f;
        for (int i = 0; i < 6; ++i) a += s[i]; for (int i = 6; i < 10; ++i) b += s[i]; for (int i = 10; i < 16; ++i) c += s[i];
        rb[tid][0] = rsqrtf(a / 384.f + EPS); rb[tid][1] = rsqrtf(b / 256.f + EPS); rb[tid][2] = rsqrtf(c / 384.f + EPS); }
    __syncthreads();
    float acc[4][4] = {};
    for (int k0 = 0; k0 < DM; k0 += 16) {
        const int br = k0 < 384 ? 0 : (k0 < 640 ? 1 : 2);
        { const int r = tid >> 2, kk = (tid & 3) * 4; const ushort4 a = *(const ushort4*)(proj + (size_t)(row0 + r) * INW + colmap(k0 + kk)); const float sc = rb[r][br];
          As[kk][r] = bf2f(a.x) * sc * gain[k0 + kk]; As[kk + 1][r] = bf2f(a.y) * sc * gain[k0 + kk + 1]; As[kk + 2][r] = bf2f(a.z) * sc * gain[k0 + kk + 2]; As[kk + 3][r] = bf2f(a.w) * sc * gain[k0 + kk + 3]; }
        { const int kr = tid >> 4, c = (tid & 15) * 4; const float4 b = *(const float4*)(W + (size_t)(k0 + kr) * DM + n0 + c);
          Bs[kr][c] = b.x; Bs[kr][c + 1] = b.y; Bs[kr][c + 2] = b.z; Bs[kr][c + 3] = b.w; }
        __syncthreads();
#pragma unroll
        for (int kk = 0; kk < 16; ++kk) {
            float a[4], b[4];
#pragma unroll
            for (int i = 0; i < 4; ++i) { a[i] = As[kk][ty * 4 + i]; b[i] = Bs[kk][tx * 4 + i]; }
#pragma unroll
            for (int i = 0; i < 4; ++i)
#pragma unroll
                for (int j = 0; j < 4; ++j) acc[i][j] += a[i] * b[j];
        }
        __syncthreads();
    }
#pragma unroll
    for (int i = 0; i < 4; ++i) { float s = 0.f; ushort4 w; w.x = f2bf(acc[i][0]); w.y = f2bf(acc[i][1]); w.z = f2bf(acc[i][2]); w.w = f2bf(acc[i][3]);
#pragma unroll
        for (int j = 0; j < 4; ++j) s += acc[i][j] * acc[i][j];
        red[ty * 4 + i][tx] = s;
        *(ushort4*)(raw + (size_t)(row0 + ty * 4 + i) * DM + n0 + tx * 4) = w; }
    __syncthreads();
    if (tid < 64) { float s = 0.f; for (int i = 0; i < 16; ++i) s += red[tid][i]; ssq2[(size_t)(row0 + tid) * 16 + blockIdx.y] = s; }
}
__global__ void k_finish(const float* xp, const float* xs, int from_out, float* out, bf16_t* U, const float* ssq2, const float* gpost, float* rpre) {
    const int row = blockIdx.x, tid = threadIdx.x;
    const float* x = from_out ? out + (size_t)row * DM : (row < NPROW ? xp + (size_t)row * DM : xs + (size_t)(row - NPROW) * DM);
    float s2 = 0.f; for (int i = 0; i < 16; ++i) s2 += ssq2[(size_t)row * 16 + i];
    const float r = rsqrtf(s2 / DM + EPS);
    const float4 v = ((const float4*)x)[tid]; const float4 g = ((const float4*)gpost)[tid];
    const ushort4 rw = ((const ushort4*)(U + (size_t)row * DM))[tid];
    float4 n; n.x = v.x + bf2f(rw.x) * r * g.x; n.y = v.y + bf2f(rw.y) * r * g.y; n.z = v.z + bf2f(rw.z) * r * g.z; n.w = v.w + bf2f(rw.w) * r * g.w;
    ((float4*)(out + (size_t)row * DM))[tid] = n;
    float s = n.x * n.x + n.y * n.y + n.z * n.z + n.w * n.w;
    __shared__ float red[4];
    for (int o = 32; o; o >>= 1) s += __shfl_xor(s, o);
    if ((tid & 63) == 0) red[tid >> 6] = s;
    __syncthreads();
    s = red[0] + red[1] + red[2] + red[3];
    if (tid == 0) rpre[row] = rsqrtf(s / DM + EPS);
    ushort4 o; o.x = f2bf(n.x); o.y = f2bf(n.y); o.z = f2bf(n.z); o.w = f2bf(n.w);
    ((ushort4*)(U + (size_t)row * DM))[tid] = o;
}
}

extern "C" void kernel_launch(void* const* d_in, const int* in_sizes, int n_in, void* d_out, int out_size, void* d_ws, size_t ws_size, hipStream_t stream) {
    using namespace nv;
    const float* xp = (const float*)d_in[0]; const float* xs = (const float*)d_in[1]; const float* norm_pre = (const float*)d_in[2]; const float* w_in = (const float*)d_in[3];
    const float* q_norm = (const float*)d_in[4]; const float* k_norm = (const float*)d_in[5]; const float* rel_bias = (const float*)d_in[6]; const float* branch_gain = (const float*)d_in[7];
    const float* w_out = (const float*)d_in[8]; const float* norm_post = (const float*)d_in[9];
    unsigned char* ws = (unsigned char*)d_ws; float* out = (float*)d_out;
    bf16_t* proj = (bf16_t*)(ws + WS_PROJ); bf16_t* U = (bf16_t*)(ws + WS_U); float* ssq = (float*)(ws + WS_SSQ); float* ssq2 = (float*)(ws + WS_SSQ2); float* rpre = (float*)(ws + WS_RPRE);
    float* tabA = (float*)(ws + WS_TABA); float* tabR = (float*)(ws + WS_TABR); float* tabC = (float*)(ws + WS_TABC);
    if (ws_size < WS_END) return;
    k_tables<<<(8192 * 8 + 255) / 256, 256, 0, stream>>>(tabA, tabR, tabC);
    k_prep<<<NTOK, 256, 0, stream>>>(xp, xs, U, rpre);
    for (int l = 0; l < 2; ++l) {
        k_inproj<<<dim3(NTOK / 64, 60), 256, 0, stream>>>(U, rpre, w_in + (size_t)l * DM * INW, norm_pre + l * DM, q_norm + l * 64, k_norm + l * 64, tabA, tabR, tabC, proj);
        k_attnB<<<dim3(192, 4), 256, 0, stream>>>(proj, ssq);
        k_attnA<<<dim3(NTOK / 256, 6), 256, 0, stream>>>(proj, ssq);
        k_attnC<<<dim3(NTOK / 256, 6), 256, 0, stream>>>(proj, rel_bias + (size_t)l * 6 * 15 * 31, ssq);
        k_outproj<<<dim3(NTOK / 64, 16), 256, 0, stream>>>(proj, ssq, w_out + (size_t)l * DM * DM, branch_gain + l * DM, U, ssq2);
        k_finish<<<NTOK, 256, 0, stream>>>(xp, xs, l, out, U, ssq2, norm_post + l * DM, rpre);
    }
}
```

```cpp
#define MIX 64
#include <hip/hip_runtime.h>
#include <hip/hip_bf16.h>
#include <cstdio>
#include <cstdint>
#include <cmath>
__device__ __forceinline__ int tidx() { int t = threadIdx.x; asm volatile("" : "+v"(t)); return t; }
template <class T> __device__ __forceinline__ T* opaque_s(T* p) { asm volatile("" : "+s"(p)); return p; }
#if defined(MIX) && MIX != 0
namespace nv {
constexpr int DM = 1024, NTOK = 49152, NPROW = 16384, SEQP = 8192, SEQS = 2048, INW = 3840;
constexpr float EPS = 1e-6f;
typedef unsigned short bf16_t;
__device__ __forceinline__ bf16_t f2bf(float f) { unsigned u = __float_as_uint(f); u += 0x7fffu + ((u >> 16) & 1u); return (bf16_t)(u >> 16); }
__device__ __forceinline__ float bf2f(bf16_t b) { return __uint_as_float(((unsigned)b) << 16); }
__device__ __forceinline__ void row_info(int row, int& base, int& S, int& t) {
    if (row < NPROW) { S = SEQP; base = row & ~(SEQP - 1); t = row & (SEQP - 1); }
    else { S = SEQS; const int r = row - NPROW; base = NPROW + (r & ~(SEQS - 1)); t = r & (SEQS - 1); }
}
constexpr size_t WS_PROJ = 0;
constexpr size_t WS_U = WS_PROJ + (size_t)NTOK * INW * 2;
constexpr size_t WS_SSQ = WS_U + (size_t)NTOK * DM * 2;
constexpr size_t WS_SSQ2 = WS_SSQ + (size_t)NTOK * 16 * 4;
constexpr size_t WS_RPRE = WS_SSQ2 + (size_t)NTOK * 16 * 4;
constexpr size_t WS_TABA = WS_RPRE + (size_t)NTOK * 4;
constexpr size_t WS_TABR = WS_TABA + (size_t)8192 * 16 * 4;
constexpr size_t WS_TABC = WS_TABR + (size_t)128 * 32 * 4;
constexpr size_t WS_END = WS_TABC + (size_t)64 * 32 * 4;

__global__ void k_tables(float* tabA, float* tabR, float* tabC) {
    const int i = blockIdx.x * blockDim.x + threadIdx.x;
    if (i < 8192 * 8) { const int t = i >> 3, j = i & 7; const double f = pow(500000.0, -(double)j / 8.0); const double a = (double)t * f; tabA[t * 16 + j] = (float)cos(a); tabA[t * 16 + 8 + j] = (float)sin(a); }
    if (i < 128 * 16) { const int t = i >> 4, j = i & 15; const double f = pow(10000.0, -(double)j / 16.0); const double a = (double)t * f; tabR[t * 32 + j] = (float)cos(a); tabR[t * 32 + 16 + j] = (float)sin(a); }
    if (i < 64 * 16) { const int t = i >> 4, j = i & 15; const double f = pow(10000.0, -(double)j / 16.0); const double a = (double)t * f; tabC[t * 32 + j] = (float)cos(a); tabC[t * 32 + 16 + j] = (float)sin(a); }
}
__global__ void k_prep(const float* xp, const float* xs, bf16_t* xb, float* rpre) {
    const int row = blockIdx.x, tid = threadIdx.x;
    const float* x = row < NPROW ? xp + (size_t)row * DM : xs + (size_t)(row - NPROW) * DM;
    const float4 v = ((const float4*)x)[tid];
    float s = v.x * v.x + v.y * v.y + v.z * v.z + v.w * v.w;
    __shared__ float red[4];
    for (int o = 32; o; o >>= 1) s += __shfl_xor(s, o);
    if ((tid & 63) == 0) red[tid >> 6] = s;
    __syncthreads();
    s = red[0] + red[1] + red[2] + red[3];
    if (tid == 0) rpre[row] = rsqrtf(s / DM + EPS);
    ushort4 o; o.x = f2bf(v.x); o.y = f2bf(v.y); o.z = f2bf(v.z); o.w = f2bf(v.w);
    ((ushort4*)(xb + (size_t)row * DM))[tid] = o;
}
__global__ void __launch_bounds__(256) k_inproj(const bf16_t* xb, const float* rpre, const float* W  , const float* gpre, const float* qn, const float* kn,
                                                const float* tabA, const float* tabR, const float* tabC, bf16_t* proj) {
    __shared__ float As[16][68], Bs[16][68], Ct[64][65];
    const int tid = threadIdx.x, tx = tid & 15, ty = tid >> 4, row0 = blockIdx.x * 64, hidx = blockIdx.y, n0 = hidx * 64;
    float acc[4][4] = {};
    for (int k0 = 0; k0 < DM; k0 += 16) {
        { const int r = tid >> 2, kk = (tid & 3) * 4; const ushort4 a = *(const ushort4*)(xb + (size_t)(row0 + r) * DM + k0 + kk);
          As[kk][r] = bf2f(a.x); As[kk + 1][r] = bf2f(a.y); As[kk + 2][r] = bf2f(a.z); As[kk + 3][r] = bf2f(a.w); }
        { const int kr = tid >> 4, c = (tid & 15) * 4; const float4 b = *(const float4*)(W + (size_t)(k0 + kr) * INW + n0 + c); const float g = gpre[k0 + kr];
          Bs[kr][c] = b.x * g; Bs[kr][c + 1] = b.y * g; Bs[kr][c + 2] = b.z * g; Bs[kr][c + 3] = b.w * g; }
        __syncthreads();
#pragma unroll
        for (int kk = 0; kk < 16; ++kk) {
            float a[4], b[4];
#pragma unroll
            for (int i = 0; i < 4; ++i) { a[i] = As[kk][ty * 4 + i]; b[i] = Bs[kk][tx * 4 + i]; }
#pragma unroll
            for (int i = 0; i < 4; ++i)
#pragma unroll
                for (int j = 0; j < 4; ++j) acc[i][j] += a[i] * b[j];
        }
        __syncthreads();
    }
#pragma unroll
    for (int i = 0; i < 4; ++i) { const float r = rpre[row0 + ty * 4 + i];
#pragma unroll
        for (int j = 0; j < 4; ++j) Ct[ty * 4 + i][tx * 4 + j] = acc[i][j] * r; }
    __syncthreads();
    if (tid < 64) {
        const int row = row0 + tid; int base, S, t; row_info(row, base, S, t);
        float v[64];
#pragma unroll
        for (int d = 0; d < 64; ++d) v[d] = Ct[tid][d];
        if (hidx < 12) {
            const float* tb = tabA + t * 16;
#pragma unroll
            for (int j = 0; j < 8; ++j) { const float c = tb[j], s = tb[8 + j], x1 = v[j], x2 = v[8 + j]; v[j] = x1 * c - x2 * s; v[8 + j] = x2 * c + x1 * s; }
        } else if (hidx >= 24 && hidx < 30) {
            const float* g = hidx < 28 ? qn : kn;
            float s = 0.f;
#pragma unroll
            for (int d = 0; d < 64; ++d) s += v[d] * v[d];
            const float r = rsqrtf(s / 64.f + EPS);
#pragma unroll
            for (int d = 0; d < 64; ++d) v[d] = v[d] * r * g[d];
            const float* tr = tabR + (t >> 6) * 32; const float* tc = tabC + (t & 63) * 32;
#pragma unroll
            for (int j = 0; j < 16; ++j) { float c = tr[j], sn = tr[16 + j], x1 = v[j], x2 = v[16 + j]; v[j] = x1 * c - x2 * sn; v[16 + j] = x2 * c + x1 * sn;
                c = tc[j]; sn = tc[16 + j]; x1 = v[32 + j]; x2 = v[48 + j]; v[32 + j] = x1 * c - x2 * sn; v[48 + j] = x2 * c + x1 * sn; }
        }
        bf16_t* o = proj + (size_t)row * INW + n0;
#pragma unroll
        for (int d = 0; d < 64; d += 4) { ushort4 w; w.x = f2bf(v[d]); w.y = f2bf(v[d + 1]); w.z = f2bf(v[d + 2]); w.w = f2bf(v[d + 3]); *(ushort4*)(o + d) = w; }
    }
}
__device__ __forceinline__ float silu(float z) { return z / (1.f + __expf(-z)); }
__global__ void __launch_bounds__(256) k_attnB(bf16_t* proj, float* ssq, float qs) {
    __shared__ float Ks[64][64], Vs[64][64];
    const int tid = threadIdx.x, h = blockIdx.y, kvh = h >> 1;
    int qb = blockIdx.x, base, S;
    if (qb < 64) { base = (qb >> 5) * SEQP; S = SEQP; qb &= 31; } else { qb -= 64; base = NPROW + (qb >> 3) * SEQS; S = SEQS; qb &= 7; }
    const int row = base + qb * 256 + tid;
    bf16_t* qp = proj + (size_t)row * INW + 1536 + h * 64;
    float q[64], o[64];
#pragma unroll
    for (int d = 0; d < 64; ++d) { q[d] = bf2f(qp[d]) * qs; o[d] = 0.f; }
    float m = -1e30f, l = 0.f;
    for (int kt = 0; kt < S; kt += 64) {
        { const int r = tid >> 2, d0 = (tid & 3) * 16; const bf16_t* kp = proj + (size_t)(base + kt + r) * INW + 1792 + kvh * 64 + d0; const bf16_t* vp = proj + (size_t)(base + kt + r) * INW + 1920 + kvh * 64 + d0;
#pragma unroll
          for (int i = 0; i < 16; ++i) { Ks[r][d0 + i] = bf2f(kp[i]); Vs[r][d0 + i] = bf2f(vp[i]); } }
        __syncthreads();
        for (int j0 = 0; j0 < 64; j0 += 8) {
            float s[8]; float cm = -1e30f;
#pragma unroll
            for (int j = 0; j < 8; ++j) { float a = 0.f;
#pragma unroll
                for (int d = 0; d < 64; ++d) a += q[d] * Ks[j0 + j][d];
                s[j] = a; cm = fmaxf(cm, a); }
            const float mn = fmaxf(m, cm), corr = __expf(m - mn); m = mn; l *= corr;
#pragma unroll
            for (int d = 0; d < 64; ++d) o[d] *= corr;
#pragma unroll
            for (int j = 0; j < 8; ++j) { const float p = __expf(s[j] - mn); l += p;
#pragma unroll
                for (int d = 0; d < 64; ++d) o[d] += p * Vs[j0 + j][d]; }
        }
        __syncthreads();
    }
    const float il = 1.f / l; const bf16_t* zp = proj + (size_t)row * INW + 2048 + h * 64; float sq = 0.f;
#pragma unroll
    for (int d = 0; d < 64; ++d) { const float y = o[d] * il * silu(bf2f(zp[d])); const bf16_t yb = f2bf(y); const float yr = bf2f(yb); sq += yr * yr; qp[d] = yb; }
    ssq[(size_t)row * 16 + 6 + h] = sq;
}
__global__ void __launch_bounds__(256) k_attnA(bf16_t* proj, float* ssq, float qs) {
    const int row = blockIdx.x * 256 + threadIdx.x, h = blockIdx.y; int base, S, t; row_info(row, base, S, t);
    bf16_t* qp = proj + (size_t)row * INW + h * 64;
    float q[64], o[64];
#pragma unroll
    for (int d = 0; d < 64; ++d) { q[d] = bf2f(qp[d]) * qs; o[d] = 0.f; }
    float m = -1e30f, l = 0.f;
    for (int p = 0; p < 3; ++p) { const int dil = p == 0 ? 1 : (p == 1 ? 4 : 16);
        for (int dlt = -64; dlt <= 64; ++dlt) { const int tk = t + dlt * dil; if (tk < 0 || tk >= S) continue;
            const bf16_t* kp = proj + (size_t)(base + tk) * INW + 384 + h * 64; const bf16_t* vp = kp + 384;
            float s = 0.f;
#pragma unroll
            for (int d = 0; d < 64; ++d) s += q[d] * bf2f(kp[d]);
            const float mn = fmaxf(m, s), corr = __expf(m - mn), pr = __expf(s - mn); m = mn; l = l * corr + pr;
#pragma unroll
            for (int d = 0; d < 64; ++d) o[d] = o[d] * corr + pr * bf2f(vp[d]); } }
    const float il = 1.f / l; const bf16_t* zp = proj + (size_t)row * INW + 1152 + h * 64; float sq = 0.f;
    bf16_t* yp = qp;
#pragma unroll
    for (int d = 0; d < 64; ++d) { const float y = o[d] * il * silu(bf2f(zp[d])); const bf16_t yb = f2bf(y); const float yr = bf2f(yb); sq += yr * yr; yp[d] = yb; }
    ssq[(size_t)row * 16 + h] = sq;
}
__global__ void __launch_bounds__(256) k_attnC(bf16_t* proj, const float* relb  , float* ssq, float qs) {
    const int row = blockIdx.x * 256 + threadIdx.x, h = blockIdx.y; int base, S, t; row_info(row, base, S, t);
    const int R = S >> 6, gr = t >> 6, gc = t & 63;
    int rs = gr - 4; rs = rs < 0 ? 0 : (rs > R - 8 ? R - 8 : rs);
    int cs = gc - 8; cs = cs < 0 ? 0 : (cs > 48 ? 48 : cs);
    bf16_t* qp = proj + (size_t)row * INW + 2304 + h * 64;
    float q[64], o[64];
#pragma unroll
    for (int d = 0; d < 64; ++d) { q[d] = bf2f(qp[d]) * qs; o[d] = 0.f; }
    float m = -1e30f, l = 0.f;
    for (int i = 0; i < 8; ++i) { const int kr = rs + i, ro = kr - gr + 7;
        for (int j = 0; j < 16; ++j) { const int kc = cs + j; int co = kc - gc + 15; co = co < 0 ? 0 : (co > 30 ? 30 : co);
            const int tk = kr * 64 + kc;
            const bf16_t* kp = proj + (size_t)(base + tk) * INW + 2688 + h * 64; const bf16_t* vp = kp + 384;
            float s = relb[(h * 15 + ro) * 31 + co];
#pragma unroll
            for (int d = 0; d < 64; ++d) s += q[d] * bf2f(kp[d]);
            const float mn = fmaxf(m, s), corr = __expf(m - mn), pr = __expf(s - mn); m = mn; l = l * corr + pr;
#pragma unroll
            for (int d = 0; d < 64; ++d) o[d] = o[d] * corr + pr * bf2f(vp[d]); } }
    const float il = 1.f / l; const bf16_t* zp = proj + (size_t)row * INW + 3456 + h * 64; float sq = 0.f;
#pragma unroll
    for (int d = 0; d < 64; ++d) { const float y = o[d] * il * silu(bf2f(zp[d])); const bf16_t yb = f2bf(y); const float yr = bf2f(yb); sq += yr * yr; qp[d] = yb; }
    ssq[(size_t)row * 16 + 10 + h] = sq;
}
__device__ __forceinline__ int colmap(int k) { return k < 384 ? k : (k < 640 ? 1536 + (k - 384) : 2304 + (k - 640)); }
__global__ void __launch_bounds__(256) k_outproj(const bf16_t* proj, const float* ssq, const float* W  , const float* gain, bf16_t* raw, float* ssq2) {
    __shared__ float As[16][68], Bs[16][68], rb[64][3], red[64][17];
    const int tid = threadIdx.x, tx = tid & 15, ty = tid >> 4, row0 = blockIdx.x * 64, n0 = blockIdx.y * 64;
    if (tid < 64) { const float* s = ssq + (size_t)(row0 + tid) * 16; float a = 0.f, b = 0.f, c = 0.f;
        for (int i = 0; i < 6; ++i) a += s[i]; for (int i = 6; i < 10; ++i) b += s[i]; for (int i = 10; i < 16; ++i) c += s[i];
        rb[tid][0] = rsqrtf(a / 384.f + EPS); rb[tid][1] = rsqrtf(b / 256.f + EPS); rb[tid][2] = rsqrtf(c / 384.f + EPS); }
    __syncthreads();
    float acc[4][4] = {};
    for (int k0 = 0; k0 < DM; k0 += 16) {
        const int br = k0 < 384 ? 0 : (k0 < 640 ? 1 : 2);
        { const int r = tid >> 2, kk = (tid & 3) * 4; const ushort4 a = *(const ushort4*)(proj + (size_t)(row0 + r) * INW + colmap(k0 + kk)); const float sc = rb[r][br];
          As[kk][r] = bf2f(a.x) * sc * gain[k0 + kk]; As[kk + 1][r] = bf2f(a.y) * sc * gain[k0 + kk + 1]; As[kk + 2][r] = bf2f(a.z) * sc * gain[k0 + kk + 2]; As[kk + 3][r] = bf2f(a.w) * sc * gain[k0 + kk + 3]; }
        { const int kr = tid >> 4, c = (tid & 15) * 4; const float4 b = *(const float4*)(W + (size_t)(k0 + kr) * DM + n0 + c);
          Bs[kr][c] = b.x; Bs[kr][c + 1] = b.y; Bs[kr][c + 2] = b.z; Bs[kr][c + 3] = b.w; }
        __syncthreads();
#pragma unroll
        for (int kk = 0; kk < 16; ++kk) {
            float a[4], b[4];
#pragma unroll
            for (int i = 0; i < 4; ++i) { a[i] = As[kk][ty * 4 + i]; b[i] = Bs[kk][tx * 4 + i]; }
#pragma unroll
            for (int i = 0; i < 4; ++i)
#pragma unroll
                for (int j = 0; j < 4; ++j) acc[i][j] += a[i] * b[j];
        }
        __syncthreads();
    }
#pragma unroll
    for (int i = 0; i < 4; ++i) { float s = 0.f; ushort4 w; w.x = f2bf(acc[i][0]); w.y = f2bf(acc[i][1]); w.z = f2bf(acc[i][2]); w.w = f2bf(acc[i][3]);
#pragma unroll
        for (int j = 0; j < 4; ++j) s += acc[i][j] * acc[i][j];
        red[ty * 4 + i][tx] = s;
        *(ushort4*)(raw + (size_t)(row0 + ty * 4 + i) * DM + n0 + tx * 4) = w; }
    __syncthreads();
    if (tid < 64) { float s = 0.f; for (int i = 0; i < 16; ++i) s += red[tid][i]; ssq2[(size_t)(row0 + tid) * 16 + blockIdx.y] = s; }
}
__global__ void k_finish(const float* xp, const float* xs, int from_out, float* out, bf16_t* U, const float* ssq2, const float* gpost, float* rpre) {
    const int row = blockIdx.x, tid = threadIdx.x;
    const float* x = from_out ? out + (size_t)row * DM : (row < NPROW ? xp + (size_t)row * DM : xs + (size_t)(row - NPROW) * DM);
    float s2 = 0.f; for (int i = 0; i < 16; ++i) s2 += ssq2[(size_t)row * 16 + i];
    const float r = rsqrtf(s2 / DM + EPS);
    const float4 v = ((const float4*)x)[tid]; const float4 g = ((const float4*)gpost)[tid];
    const ushort4 rw = ((const ushort4*)(U + (size_t)row * DM))[tid];
    float4 n; n.x = v.x + bf2f(rw.x) * r * g.x; n.y = v.y + bf2f(rw.y) * r * g.y; n.z = v.z + bf2f(rw.z) * r * g.z; n.w = v.w + bf2f(rw.w) * r * g.w;
    ((float4*)(out + (size_t)row * DM))[tid] = n;
    float s = n.x * n.x + n.y * n.y + n.z * n.z + n.w * n.w;
    __shared__ float red[4];
    for (int o = 32; o; o >>= 1) s += __shfl_xor(s, o);
    if ((tid & 63) == 0) red[tid >> 6] = s;
    __syncthreads();
    s = red[0] + red[1] + red[2] + red[3];
    if (tid == 0) rpre[row] = rsqrtf(s / DM + EPS);
    ushort4 o; o.x = f2bf(n.x); o.y = f2bf(n.y); o.z = f2bf(n.z); o.w = f2bf(n.w);
    ((ushort4*)(U + (size_t)row * DM))[tid] = o;
}
}
#endif
namespace pg8 {
#define PG8_LAS __attribute__((address_space(3)))
typedef unsigned short bf16_t;
typedef short bf16x8 __attribute__((ext_vector_type(8)));
typedef float f32x4 __attribute__((ext_vector_type(4)));
typedef unsigned u32x4 __attribute__((ext_vector_type(4)));
constexpr int BM = 256, BK = 64, HALF = 128, HTB = HALF * BK * 2  , STAGE_BYTES = 8 * HTB, NXCD = 8, WGM = 8;

__host__ __device__ __forceinline__ int lds_byte(int r, int c) { const int st = (r >> 4) * 2 + (c >> 5), rr = r & 15, cc = c & 31, ob = rr * 64 + cc * 2; return st * 1024 + (ob ^ (((ob >> 9) & 1) << 5)); }
__host__ __device__ __forceinline__ void stage_rc(int b, int& R, int& C) { const int st = b / 1024, sb = b % 1024, swz = sb ^ (((sb >> 9) & 1) << 5); R = (st >> 1) * 16 + swz / 64; C = (st & 1) * 32 + (swz % 64) / 2; }
__host__ __device__ __forceinline__ int perm32(int rho) { const int n = rho >> 4, i = rho & 15; return 8 * (i >> 2) + 4 * n + (i & 3); }

struct Unit { int pm, pn; };
struct Gemm { const bf16_t* A; const bf16_t* Bt; int M, N, K, lda; };

struct StaticOrder {
    int nM, nN, nwg, G, c;
    __host__ __device__ void init(int M, int N, int G_, int c_) { nM = M / BM; nN = N / BM; nwg = nM * nN; G = G_; c = c_; }
    __host__ __device__ bool next(int i, Unit& u) const {
        const long L = (long)i * G + c; if (L >= nwg) return false;
        int wgid = (int)L; { const int q = nwg / NXCD, r = nwg % NXCD, xcd = wgid % NXCD, off = wgid / NXCD; wgid = (xcd < r ? xcd * (q + 1) : r * (q + 1) + (xcd - r) * q) + off; }
        const int nig = WGM * nN, gid = wgid / nig, fm = gid * WGM, gsz = (nM - fm) < WGM ? (nM - fm) : WGM;
        u.pm = fm + ((wgid % nig) % gsz); u.pn = (wgid % nig) / gsz; return true;
    }
    __device__ __forceinline__ void a_ready(const Unit&) const {}
    __device__ __forceinline__ void done(const Unit&) const {}
};

__device__ __forceinline__ unsigned cvt_pk_bf16(float lo, float hi) { unsigned r; asm volatile("v_cvt_pk_bf16_f32 %0, %1, %2" : "=v"(r) : "v"(lo), "v"(hi)); return r; }
constexpr float QC2 = 0.125f * 1.4426950408889634f;
constexpr float EPSN = 1e-6f;
__device__ __forceinline__ int row_pos(int row) { return row < 16384 ? (row & 8191) : ((row - 16384) & 2047); }

struct EpiProj {
    static constexpr bool PERM = true, AFTER_DRAIN = false;
    bf16_t* proj; const float* rpre; const float* qn; const float* kn; const float* tabA; const float* tabR; const float* tabC;
    __device__ __forceinline__ void ustart(const Unit&, int, PG8_LAS unsigned char*) const {}
    __device__ __forceinline__ void khook(f32x4 (&)[2][2][4][2], const Unit&, int, int, int, int, PG8_LAS unsigned char*) const {}
    __device__ __forceinline__ void operator()(const f32x4 (&acc)[2][2][4][2], const Unit& u, int ui, int wr, int wc, int fr, int fq, PG8_LAS unsigned char* lds) const {
        const int hidx = u.pn * 4 + wc;
        const int type = hidx < 12 ? 1 : ((hidx >= 24 && hidx < 30) ? 2 : 0);
        const bool qsc = (hidx < 6) || (hidx >= 24 && hidx < 28) || (hidx >= 36 && hidx < 42);
        const float osc = qsc ? QC2 : 1.0f;
        const float* gv = hidx < 28 ? qn : kn;
        bf16_t* obase = proj + (size_t)hidx * 64 + 8 * fq;
#pragma unroll
        for (int ai = 0; ai < 2; ++ai)
#pragma unroll
            for (int m = 0; m < 4; ++m) {
                const int row = u.pm * BM + ai * HALF + wr * 64 + m * 16 + fr; const int t = row_pos(row);
                const float rp = rpre[row];
                f32x4 v[2][2];
#pragma unroll
                for (int bj = 0; bj < 2; ++bj)
#pragma unroll
                    for (int n = 0; n < 2; ++n) v[bj][n] = acc[ai][bj][m][n] * rp;
                if (type == 1) {
                    const float sg = fq == 0 ? -1.f : 1.f; const bool on = fq < 2;
#pragma unroll
                    for (int n = 0; n < 2; ++n) { const f32x4 c4 = *(const f32x4*)(tabA + t * 16 + 4 * n), s4 = *(const f32x4*)(tabA + t * 16 + 8 + 4 * n);
#pragma unroll
                        for (int e = 0; e < 4; ++e) { const float own = v[0][n][e], oth = __shfl_xor(own, 16); const float nv_ = own * c4[e] + sg * oth * s4[e]; v[0][n][e] = on ? nv_ : own; } }
                } else if (type == 2) {
                    float ss = 0.f;
#pragma unroll
                    for (int bj = 0; bj < 2; ++bj)
#pragma unroll
                        for (int n = 0; n < 2; ++n) ss += (v[bj][n][0] * v[bj][n][0] + v[bj][n][1] * v[bj][n][1]) + (v[bj][n][2] * v[bj][n][2] + v[bj][n][3] * v[bj][n][3]);
                    ss += __shfl_xor(ss, 16); ss += __shfl_xor(ss, 32);
                    const float rn = rsqrtf(ss * (1.0f / 64.0f) + EPSN);
#pragma unroll
                    for (int bj = 0; bj < 2; ++bj)
#pragma unroll
                        for (int n = 0; n < 2; ++n) { const f32x4 g4 = *(const f32x4*)(gv + 32 * bj + 8 * fq + 4 * n); v[bj][n] = v[bj][n] * rn * g4; }
                    const float sg = fq < 2 ? -1.f : 1.f;
#pragma unroll
                    for (int bj = 0; bj < 2; ++bj) { const float* tb = bj == 0 ? tabR + (t >> 6) * 32 : tabC + (t & 63) * 32;
#pragma unroll
                        for (int n = 0; n < 2; ++n) { const f32x4 c4 = *(const f32x4*)(tb + 8 * (fq & 1) + 4 * n), s4 = *(const f32x4*)(tb + 16 + 8 * (fq & 1) + 4 * n);
#pragma unroll
                            for (int e = 0; e < 4; ++e) { const float own = v[bj][n][e], oth = __shfl_xor(own, 32); v[bj][n][e] = own * c4[e] + sg * oth * s4[e]; } } }
                }
                bf16_t* rowp = obase + (size_t)row * 3840;
#pragma unroll
                for (int bj = 0; bj < 2; ++bj) { const f32x4 v0 = v[bj][0] * osc, v1 = v[bj][1] * osc; u32x4 w; w.x = cvt_pk_bf16(v0[0], v0[1]); w.y = cvt_pk_bf16(v0[2], v0[3]); w.z = cvt_pk_bf16(v1[0], v1[1]); w.w = cvt_pk_bf16(v1[2], v1[3]);
                    *(u32x4*)(rowp + 32 * bj) = w; }
                asm volatile("" ::: "memory");
            }
    }
};

constexpr int FT_OFF = 131072;
struct EpiRaw {
    static constexpr bool PERM = true, AFTER_DRAIN = false;
    bf16_t* raw; float* ssq2; const float* ssq;
    __device__ __forceinline__ void ustart(const Unit& u, int ui, PG8_LAS unsigned char* lds) const {
        const int tid = tidx();
        if (tid < 256) { const f32x4* s = (const f32x4*)(ssq + (size_t)(u.pm * BM + tid) * 16); const f32x4 a = s[0], b = s[1], c = s[2], d = s[3];
            const float sa = (a[0] + a[1]) + (a[2] + a[3]) + (b[0] + b[1]), sb = (b[2] + b[3]) + (c[0] + c[1]), sc = (c[2] + c[3]) + (d[0] + d[1]) + (d[2] + d[3]);
            const float rA = rsqrtf(sa * (1.0f / 384.0f) + EPSN), rB = rsqrtf(sb * (1.0f / 256.0f) + EPSN), rC = rsqrtf(sc * (1.0f / 384.0f) + EPSN);
            *(PG8_LAS f32x4*)(lds + FT_OFF + (ui & 1) * 4096 + tid * 16) = (f32x4){rA / rB, rB / rC, rC, 0.f}; }
    }
    __device__ __forceinline__ void khook(f32x4 (&acc)[2][2][4][2], const Unit&, int t, int ui, int wr, int fr, PG8_LAS unsigned char* lds) const {
        const int tq = t;
        if (tq == 6 || tq == 10) { int b = (wr * 64 + fr) * 16 + (ui & 1) * 4096 + (tq == 6 ? 0 : 4); asm volatile("" : "+v"(b));
            const PG8_LAS unsigned char* p = lds + FT_OFF + b;
#pragma unroll
            for (int ai = 0; ai < 2; ++ai)
#pragma unroll
                for (int m = 0; m < 4; ++m) { const float f = *(const PG8_LAS float*)(p + (ai * HALF + m * 16) * 16);
#pragma unroll
                    for (int bj = 0; bj < 2; ++bj)
#pragma unroll
                        for (int n = 0; n < 2; ++n) acc[ai][bj][m][n] *= f;
                    asm volatile("" ::: "memory"); } }
    }
    __device__ __forceinline__ void operator()(const f32x4 (&acc)[2][2][4][2], const Unit& u, int ui, int wr, int wc, int fr, int fq, PG8_LAS unsigned char* lds) const {
        int rl0 = wr * 64 + fr; asm volatile("" : "+v"(rl0));
        const PG8_LAS unsigned char* p = lds + FT_OFF + (ui & 1) * 4096 + rl0 * 16 + 8;
        const unsigned col0 = (unsigned)(u.pn * BM + wc * 32 + 8 * fq);
        const unsigned row0 = (unsigned)(u.pm * BM + rl0);
#pragma unroll
        for (int ai = 0; ai < 2; ++ai)
#pragma unroll
            for (int m = 0; m < 4; ++m) { const unsigned row = row0 + ai * HALF + m * 16;
                const float f = *(const PG8_LAS float*)(p + (ai * HALF + m * 16) * 16);
                float ss = 0.f; bf16_t* rowp = raw + (size_t)row * 1024 + col0;
#pragma unroll
                for (int bj = 0; bj < 2; ++bj) { const f32x4 v0 = acc[ai][bj][m][0] * f, v1 = acc[ai][bj][m][1] * f;
                    ss += (v0[0] * v0[0] + v0[1] * v0[1]) + (v0[2] * v0[2] + v0[3] * v0[3]) + (v1[0] * v1[0] + v1[1] * v1[1]) + (v1[2] * v1[2] + v1[3] * v1[3]);
                    u32x4 w; w.x = cvt_pk_bf16(v0[0], v0[1]); w.y = cvt_pk_bf16(v0[2], v0[3]); w.z = cvt_pk_bf16(v1[0], v1[1]); w.w = cvt_pk_bf16(v1[2], v1[3]);
                    *(u32x4*)(rowp + bj * HALF) = w; }
                ss += __shfl_xor(ss, 16); ss += __shfl_xor(ss, 32);
                if (fq == 0) ssq2[(size_t)row * 16 + u.pn * 4 + wc] = ss;
                asm volatile("" ::: "memory"); }
    }
};
struct AMapLin { static __device__ __forceinline__ size_t koff(int t) { return (size_t)t * 128; } };
struct AMapY { static __device__ __forceinline__ size_t koff(int t) { return (size_t)(128 * t + (t >= 6 ? 2304 : 0) + (t >= 10 ? 1024 : 0)); } };
template <class Epi, class Sched, class AMap, bool ALIGN_EPI = false, bool SP2 = false>
__device__ __forceinline__ void gemm_phase(PG8_LAS unsigned char* lds, const Gemm g, const Sched& S, const Epi& E) {
    const int tid = tidx(), wid = __builtin_amdgcn_readfirstlane(tid >> 6), lane = tid & 63, wr = wid >> 2, wc = wid & 3, fr = lane & 15, fq = lane >> 4;
    const int K = g.K, nt = K / BK;
    unsigned voffA[2], voffB[2];
#pragma unroll
    for (int i = 0; i < 2; ++i) { int R, C; stage_rc(tid * 16 + i * 8192, R, C); const int Rb = Epi::PERM ? ((R & ~31) + perm32(R & 31)) : R;
        voffA[i] = (unsigned)(R * g.lda + C) * 2u; voffB[i] = (unsigned)(Rb * K + C) * 2u; }
    const size_t kstep = (size_t)(BK * 2);
    const size_t hstep = (size_t)HALF * K * 2;
    const size_t tstep = 2 * hstep;
    const size_t hstepA = (size_t)HALF * g.lda * 2, tstepA = 2 * hstepA;
    const unsigned ldsw = (unsigned)wid * 1024u;
    const int aoff = lds_byte(wr * 64 + fr, fq * 8), boff = lds_byte(wc * 32 + fr, fq * 8);
#define PG8_SA(b, h) (((b) * 2 + (h)) * HTB)
#define PG8_SB(b, h) ((4 + (b) * 2 + (h)) * HTB)
#define PG8_STAGE(bufoff, gbase, voff) do { _Pragma("unroll") for (int _i = 0; _i < 2; ++_i) \
        __builtin_amdgcn_global_load_lds((const unsigned*)((const char*)(gbase) + (voff)[_i]), (PG8_LAS unsigned*)(lds + (bufoff) + ldsw + _i * 8192), 16, 0, 0); } while (0)
#define PG8_LDA(dst, b, h) do { _Pragma("unroll") for (int m = 0; m < 4; ++m) _Pragma("unroll") for (int k = 0; k < 2; ++k) dst[m][k] = *(const PG8_LAS bf16x8*)(lds + PG8_SA(b, h) + aoff + m * 2048 + k * 1024); } while (0)
#define PG8_LDB(dst, b, h) do { _Pragma("unroll") for (int n = 0; n < 2; ++n) _Pragma("unroll") for (int k = 0; k < 2; ++k) dst[n][k] = *(const PG8_LAS bf16x8*)(lds + PG8_SB(b, h) + boff + n * 2048 + k * 1024); } while (0)
#define PG8_MMA(ai, bj, At, Bt) do { __builtin_amdgcn_s_setprio(1); _Pragma("unroll") for (int m = 0; m < 4; ++m) _Pragma("unroll") for (int n = 0; n < 2; ++n) _Pragma("unroll") for (int k = 0; k < 2; ++k) \
        acc[ai][bj][m][n] = __builtin_amdgcn_mfma_f32_16x16x32_bf16(Bt[n][k], At[m][k], acc[ai][bj][m][n], 0, 0, 0); __builtin_amdgcn_s_setprio(0); } while (0)
#define PG8_WAIT_V(n) asm volatile("s_waitcnt vmcnt(" #n ")" ::: "memory")
#define PG8_WAIT_L(n) asm volatile("s_waitcnt lgkmcnt(" #n ")" ::: "memory")
#define PG8_BAR __builtin_amdgcn_s_barrier()
#define PG8_SCHED __builtin_amdgcn_sched_barrier(0)
    Unit cur, nxt; int ui = 0;
    if (!S.next(0, cur)) return;
    f32x4 acc[2][2][4][2];
#pragma unroll
    for (int a = 0; a < 2; ++a)
#pragma unroll
        for (int b = 0; b < 2; ++b)
#pragma unroll
            for (int m = 0; m < 4; ++m)
#pragma unroll
                for (int n = 0; n < 2; ++n) acc[a][b][m][n] = (f32x4){0.f, 0.f, 0.f, 0.f};
    bf16x8 At[4][2], B0[2][2], B1[2][2];
    const char* cA = (const char*)g.A + (size_t)cur.pm * tstepA; const char* cB = (const char*)g.Bt + (size_t)cur.pn * tstep;
    S.a_ready(cur); E.ustart(cur, 0, lds);
    if constexpr (SP2) {
        PG8_STAGE(PG8_SB(0, 0), cB, voffB); PG8_STAGE(PG8_SB(0, 1), cB + hstep, voffB); PG8_STAGE(PG8_SA(0, 0), cA, voffA); PG8_STAGE(PG8_SA(0, 1), cA + hstepA, voffA);
        if (wr == 1) PG8_BAR;
        PG8_WAIT_V(2); PG8_BAR;
        PG8_STAGE(PG8_SB(1, 0), cB + kstep, voffB); PG8_STAGE(PG8_SA(1, 0), cA + AMap::koff(1), voffA); PG8_STAGE(PG8_SB(1, 1), cB + hstep + kstep, voffB);
        PG8_WAIT_V(6); PG8_BAR;
    } else {
        PG8_STAGE(PG8_SB(0, 0), cB, voffB); PG8_STAGE(PG8_SA(0, 0), cA, voffA); PG8_STAGE(PG8_SB(0, 1), cB + hstep, voffB); PG8_STAGE(PG8_SA(0, 1), cA + hstepA, voffA);
        if (wr == 1) PG8_BAR;
        PG8_WAIT_V(4); PG8_BAR;
        PG8_STAGE(PG8_SB(1, 0), cB + kstep, voffB); PG8_STAGE(PG8_SA(1, 0), cA + AMap::koff(1), voffA); PG8_STAGE(PG8_SB(1, 1), cB + hstep + kstep, voffB);
        PG8_WAIT_V(6); PG8_BAR;
    }
    for (;;) {
        const bool has_next = S.next(ui + 1, nxt);
        const char* nA = has_next ? (const char*)g.A + (size_t)nxt.pm * tstepA : cA; const char* nB = has_next ? (const char*)g.Bt + (size_t)nxt.pn * tstep : cB;
        for (int t = 0; t < nt; t += 2) {
            const bool last = (t == nt - 2);
            int tq = t; asm volatile("" : "+s"(tq));
            const char* a1 = cA + AMap::koff(tq + 1);
            const char* a2 = last ? nA : cA + AMap::koff(tq + 2); const char* b2 = last ? nB : cB + (size_t)(t + 2) * kstep;
            const char* a3 = last ? nA + AMap::koff(1) : cA + AMap::koff(tq + 3); const char* b3 = b2 + kstep;
            E.khook(acc, cur, tq, ui, wr, fr, lds);
            if (last && has_next) S.a_ready(nxt);
            if constexpr (SP2) {
            PG8_LDB(B0, 0, 0); PG8_LDB(B1, 0, 1); PG8_SCHED; PG8_LDA(At, 0, 0); PG8_STAGE(PG8_SA(1, 1), a1 + hstepA, voffA);
            PG8_WAIT_V(8); PG8_WAIT_L(0); PG8_BAR; PG8_MMA(0, 0, At, B0); PG8_MMA(0, 1, At, B1); PG8_BAR; PG8_SCHED;
            PG8_LDA(At, 0, 1); PG8_STAGE(PG8_SB(0, 0), b2, voffB); PG8_STAGE(PG8_SB(0, 1), b2 + hstep, voffB); PG8_STAGE(PG8_SA(0, 0), a2, voffA);
            PG8_WAIT_V(8); PG8_WAIT_L(0); PG8_BAR; PG8_MMA(1, 0, At, B0); PG8_MMA(1, 1, At, B1); PG8_BAR; PG8_SCHED;
            PG8_LDB(B0, 1, 0); PG8_LDB(B1, 1, 1); PG8_SCHED; PG8_LDA(At, 1, 0); PG8_STAGE(PG8_SA(0, 1), a2 + hstepA, voffA);
            PG8_WAIT_V(8); PG8_WAIT_L(0); PG8_BAR; PG8_MMA(0, 0, At, B0); PG8_MMA(0, 1, At, B1); PG8_BAR; PG8_SCHED;
            PG8_LDA(At, 1, 1); PG8_STAGE(PG8_SB(1, 0), b3, voffB); PG8_STAGE(PG8_SB(1, 1), b3 + hstep, voffB); PG8_STAGE(PG8_SA(1, 0), a3, voffA);
            PG8_WAIT_V(8); PG8_WAIT_L(0); PG8_BAR; PG8_MMA(1, 0, At, B0); PG8_MMA(1, 1, At, B1); PG8_BAR; PG8_SCHED;
            } else {
            PG8_LDB(B0, 0, 0); PG8_SCHED; PG8_LDA(At, 0, 0); PG8_STAGE(PG8_SA(1, 1), a1 + hstepA, voffA);
            PG8_WAIT_L(8); PG8_BAR; PG8_WAIT_L(0); PG8_MMA(0, 0, At, B0); PG8_BAR; PG8_SCHED;
            PG8_LDB(B1, 0, 1); PG8_STAGE(PG8_SB(0, 0), b2, voffB);
            PG8_BAR; PG8_WAIT_L(0); PG8_MMA(0, 1, At, B1); PG8_BAR;
            PG8_LDA(At, 0, 1); PG8_STAGE(PG8_SA(0, 0), a2, voffA);
            PG8_BAR; PG8_WAIT_L(0); PG8_MMA(1, 0, At, B0); PG8_BAR; PG8_SCHED;
            PG8_STAGE(PG8_SB(0, 1), b2 + hstep, voffB);
            PG8_WAIT_V(6); PG8_BAR; PG8_MMA(1, 1, At, B1); PG8_BAR;
            PG8_LDB(B0, 1, 0); PG8_SCHED; PG8_LDA(At, 1, 0); PG8_STAGE(PG8_SA(0, 1), a2 + hstepA, voffA);
            PG8_WAIT_L(8); PG8_BAR; PG8_WAIT_L(0); PG8_MMA(0, 0, At, B0); PG8_BAR; PG8_SCHED;
            PG8_LDB(B1, 1, 1); PG8_STAGE(PG8_SB(1, 0), b3, voffB);
            PG8_BAR; PG8_WAIT_L(0); PG8_MMA(0, 1, At, B1); PG8_BAR;
            PG8_LDA(At, 1, 1); PG8_STAGE(PG8_SA(1, 0), a3, voffA);
            PG8_BAR; PG8_WAIT_L(0); PG8_MMA(1, 0, At, B0); PG8_BAR; PG8_SCHED;
            PG8_STAGE(PG8_SB(1, 1), b3 + hstep, voffB);
            PG8_WAIT_V(6); PG8_BAR; PG8_MMA(1, 1, At, B1); PG8_BAR;
            }
        }
        if constexpr (ALIGN_EPI) { if (wr == 0) PG8_BAR; }
        if constexpr (!Epi::AFTER_DRAIN) { E(acc, cur, ui, wr, wc, fr, fq, lds); S.done(cur); }
        if (!has_next) break;
        E.ustart(nxt, ui + 1, lds);
#pragma unroll
        for (int a = 0; a < 2; ++a)
#pragma unroll
            for (int b = 0; b < 2; ++b)
#pragma unroll
                for (int m = 0; m < 4; ++m)
#pragma unroll
                    for (int n = 0; n < 2; ++n) acc[a][b][m][n] = (f32x4){0.f, 0.f, 0.f, 0.f};
        cur = nxt; cA = nA; cB = nB; ++ui;
        if constexpr (ALIGN_EPI) { if (wr == 1) PG8_BAR; }
    }
    PG8_WAIT_V(0);
    if constexpr (!ALIGN_EPI) { if (wr == 0) PG8_BAR; }
    PG8_BAR;
    if constexpr (Epi::AFTER_DRAIN) { E.fused(acc, cur, wr, wc, fr, fq, lds, wid, lane); S.done(cur); }
#undef PG8_SA
#undef PG8_SB
#undef PG8_STAGE
#undef PG8_LDA
#undef PG8_LDB
#undef PG8_MMA
#undef PG8_WAIT_V
#undef PG8_WAIT_L
#undef PG8_BAR
#undef PG8_SCHED
}
}

namespace attn_body {
using bf16=__hip_bfloat16;
using bf16x8=__attribute__((ext_vector_type(8)))short;
using s16x4=__attribute__((ext_vector_type(4)))short;
using f32x16=__attribute__((ext_vector_type(16)))float;
using u32x4=__attribute__((ext_vector_type(4)))unsigned;
constexpr int D=64,DM=3840;
constexpr int NW=8,QBLK=32,QB=QBLK*NW,KVBLK=64;
__device__ __forceinline__ int crow(int r,int hi){return (r&3)+8*(r>>2)+4*hi;}
#define SBAR() __builtin_amdgcn_sched_barrier(0)
#define ATTN_STORE16(p,v) (*(u32x4*)(p)=(v))
constexpr int NSLOT=3, SLOTB=8192;
constexpr int LDS_K=0, LDS_V=NSLOT*SLOTB, LDS_WS=2*NSLOT*SLOTB, LDS_OST=LDS_WS+NW*64*4, LDS_BYTES=LDS_OST+NW*4096;
constexpr float C2=0.125f*1.4426950408889634f;
__device__ __forceinline__ void glds16(const void*gsrc,unsigned lds_dst){unsigned keep;
  asm volatile("s_mov_b32 %0, m0\n\ts_mov_b32 m0, %2\n\ts_nop 0\n\tglobal_load_lds_dwordx4 %1, off\n\ts_mov_b32 m0, %0":"=&s"(keep):"v"(gsrc),"s"(lds_dst):"memory");}
__device__ __forceinline__ float max3f(float a,float b,float c){float r;asm("v_max3_f32 %0, %1, %2, %3":"=v"(r):"v"(a),"v"(b),"v"(c));return r;}
__device__ __forceinline__ float max2f(float a,float b){float r;asm("v_max_f32_e32 %0, %1, %2":"=v"(r):"v"(a),"v"(b));return r;}
__device__ __forceinline__ float fadd_s(float a,float b){float r;asm("v_add_f32_e32 %0, %1, %2":"=v"(r):"v"(a),"v"(b));return r;}
__device__ __forceinline__ float fsub_s(float a,float b){float r;asm("v_sub_f32_e32 %0, %1, %2":"=v"(r):"v"(a),"v"(b));return r;}
typedef float f32x2_t __attribute__((ext_vector_type(2))); typedef __bf16 bf16x2_t __attribute__((ext_vector_type(2)));
__device__ __forceinline__ unsigned cvtpk_s(float lo,float hi){f32x2_t v={lo,hi};bf16x2_t b=__builtin_convertvector(v,bf16x2_t);return __builtin_bit_cast(unsigned,b);}
#define WAIT_BAR(N) asm volatile("s_waitcnt vmcnt(" #N ") lgkmcnt(0)\n\ts_barrier":::"memory")

__device__ __forceinline__ void qkt(f32x16&p0,f32x16&p1,const char*Kslot,const bf16x8*qr,const f32x16&negm,int r32,int hi){
  const char*kb=Kslot+hi*1024+r32*16;
  #pragma unroll
  for(int d0=0;d0<4;++d0){
    const bf16x8 b0=*reinterpret_cast<const bf16x8*>(kb+d0*2048);
    const bf16x8 b1=*reinterpret_cast<const bf16x8*>(kb+d0*2048+512);
    if(d0==0){p0=__builtin_amdgcn_mfma_f32_32x32x16_bf16(b0,qr[0],negm,0,0,0);p1=__builtin_amdgcn_mfma_f32_32x32x16_bf16(b1,qr[0],negm,0,0,0);}
    else{p0=__builtin_amdgcn_mfma_f32_32x32x16_bf16(b0,qr[d0],p0,0,0,0);p1=__builtin_amdgcn_mfma_f32_32x32x16_bf16(b1,qr[d0],p1,0,0,0);}}
}
typedef __attribute__((address_space(3))) const char* lds_cptr;
typedef short v4i16_t __attribute__((ext_vector_type(4)));
__device__ __forceinline__ void kload8(bf16x8*kf,lds_cptr kp){
  kf[0]=*(const __attribute__((address_space(3))) bf16x8*)(kp);      kf[1]=*(const __attribute__((address_space(3))) bf16x8*)(kp+512);
  kf[2]=*(const __attribute__((address_space(3))) bf16x8*)(kp+2048); kf[3]=*(const __attribute__((address_space(3))) bf16x8*)(kp+2560);
  kf[4]=*(const __attribute__((address_space(3))) bf16x8*)(kp+4096); kf[5]=*(const __attribute__((address_space(3))) bf16x8*)(kp+4608);
  kf[6]=*(const __attribute__((address_space(3))) bf16x8*)(kp+6144); kf[7]=*(const __attribute__((address_space(3))) bf16x8*)(kp+6656);
}
__device__ __forceinline__ void kload2(bf16x8*kf,lds_cptr kp,int j){ kf[2*j]=*(const __attribute__((address_space(3))) bf16x8*)(kp+j*2048); kf[2*j+1]=*(const __attribute__((address_space(3))) bf16x8*)(kp+j*2048+512); }
__device__ __forceinline__ s16x4 vtr(lds_cptr p){ return __builtin_bit_cast(s16x4,__builtin_amdgcn_ds_read_tr16_b64_v4i16((__attribute__((address_space(3))) v4i16_t*)p)); }
__device__ __forceinline__ float rowmax(const f32x16&p0,const f32x16&p1){
  float a=max3f(p0[0],p0[1],p1[0]),b=max3f(p0[2],p0[3],p1[1]);a=max3f(a,p1[2],p1[3]);
  #pragma unroll
  for(int r=4;r<16;r+=4){a=max3f(a,p0[r],p0[r+1]);b=max3f(b,p0[r+2],p0[r+3]);a=max3f(a,p1[r],p1[r+1]);b=max3f(b,p1[r+2],p1[r+3]);}
  const float m=max2f(a,b);
  auto rr=__builtin_amdgcn_permlane32_swap(__float_as_uint(m),__float_as_uint(m),false,false);
  return max2f(__uint_as_float(rr[0]),__uint_as_float(rr[1]));
}
__device__ __forceinline__ void pv(f32x16*o,int vb,bf16x8 pa0,bf16x8 pa1,bf16x8 pa2,bf16x8 pa3){
  #pragma unroll
  for(int d0=0;d0<2;++d0){s16x4 lo[4],hi[4];
    #pragma unroll
    for(int ks=0;ks<4;++ks){
      asm volatile("ds_read_b64_tr_b16 %0,%1 offset:%c2":"=&v"(lo[ks]):"v"(vb),"i"(d0*4096+ks*1024):"memory");
      asm volatile("ds_read_b64_tr_b16 %0,%1 offset:%c2":"=&v"(hi[ks]):"v"(vb),"i"(d0*4096+ks*1024+512):"memory");}
    asm volatile("s_waitcnt lgkmcnt(0)":::"memory");SBAR();
    #define PK(k) (bf16x8){lo[k][0],lo[k][1],lo[k][2],lo[k][3],hi[k][0],hi[k][1],hi[k][2],hi[k][3]}
    o[d0]=__builtin_amdgcn_mfma_f32_32x32x16_bf16(pa0,PK(0),o[d0],0,0,0);
    o[d0]=__builtin_amdgcn_mfma_f32_32x32x16_bf16(pa1,PK(1),o[d0],0,0,0);
    o[d0]=__builtin_amdgcn_mfma_f32_32x32x16_bf16(pa2,PK(2),o[d0],0,0,0);
    o[d0]=__builtin_amdgcn_mfma_f32_32x32x16_bf16(pa3,PK(3),o[d0],0,0,0);
    #undef PK
  }
}
template<int THRL> __device__ __forceinline__ void attn_unit(long rowbase,int S,int h,int qb,bf16*P,float*ssq,char*shm){
  const int tid=tidx(),lane=tid&63,r32=lane&31,hi=lane>>5; const int wid=__builtin_amdgcn_readfirstlane(tid>>6);
  const int q0=qb*QB;
  bf16*Qw=P+(rowbase+q0+wid*QBLK)*DM+1536+h*D;
  const bf16*Kh=P+rowbase*DM+1792+(h>>1)*D,*Vh=P+rowbase*DM+1920+(h>>1)*D;
  const unsigned lds0=(unsigned)(uintptr_t)shm;
  float*wsf=(float*)(shm+LDS_WS)+wid*64;
  const bf16*ksrc=Kh+(long)lane*DM+wid*8;
  const bf16*vsrc=Vh+(long)(16*(wid&3)+(lane>>2))*DM+(wid>>2)*32+(lane&3)*8;
  const unsigned kdst=lds0+LDS_K+wid*1024, vdst=lds0+LDS_V+wid*1024;
  #define DMA_K(t,slot) glds16(ksrc+(long)(t)*KVBLK*DM,(unsigned)__builtin_amdgcn_readfirstlane(kdst+(slot)))
  #define DMA_V(t,slot) glds16(vsrc+(long)(t)*KVBLK*DM,(unsigned)__builtin_amdgcn_readfirstlane(vdst+(slot)))
  const int vb0=(int)(lds0+LDS_V)+((lane>>4)&1)*32+(lane&3)*8+(4*hi+((lane&15)>>2))*64;
  const char*Kbase=shm+LDS_K; bf16x8 kf[8];
  const lds_cptr shm3=(lds_cptr)shm; const lds_cptr kp0=shm3+LDS_K+hi*1024+r32*16; const lds_cptr vp0=shm3+LDS_V+((lane>>4)&1)*32+(lane&3)*8+(4*hi+((lane&15)>>2))*64;
  const int NT=S/KVBLK;
  DMA_K(0,0);DMA_V(0,0);DMA_K(1,SLOTB);
  bf16x8 qr[4];
  #pragma unroll
  for(int d0=0;d0<4;++d0)qr[d0]=*reinterpret_cast<const bf16x8*>(&Qw[(long)r32*DM+d0*16+hi*8]);
  float mhat=0.f,l_reg=0.f;f32x16 o[2];o[0]=f32x16{};o[1]=f32x16{};f32x16 negm=f32x16{};asm volatile("":"+v"(negm));
  #define CMASK(P0,P1,t) do{}while(0)
  bool resc=false;
  #define START(P0,P1) do{ const float rm=rowmax(P0,P1); resc=false; \
    { const float dl=rm; mhat=fadd_s(mhat,dl); \
      _Pragma("unroll") for(int r=0;r<16;++r){P0[r]=fsub_s(P0[r],dl);P1[r]=fsub_s(P1[r],dl);} \
      _Pragma("unroll") for(int r=0;r<16;++r)negm[r]=-mhat; asm volatile("":"+v"(negm)); } \
    _Pragma("unroll") for(int r=0;r<16;++r)P0[r]=__builtin_amdgcn_exp2f(P0[r]); }while(0)
  #define RESC() do{ if(resc){ asm volatile("s_waitcnt lgkmcnt(0)":::"memory"); \
      _Pragma("unroll") for(int d_=0;d_<2;++d_) _Pragma("unroll") for(int r=0;r<16;++r)o[d_][r]*=wsf[crow(r,hi)]; } }while(0)
  f32x16 pA0,pA1,pB0,pB1;
  int sl_prev=0,sl_cur=0,sl_next=SLOTB;
  #define ROT() do{sl_prev=sl_cur;sl_cur=sl_next;sl_next=(sl_next==(NSLOT-1)*SLOTB)?0:sl_next+SLOTB;}while(0)
  DMA_K(2,2*SLOTB);
  WAIT_BAR(3);
  qkt(pA0,pA1,Kbase,qr,negm,r32,hi);asm volatile("s_nop 15\n\ts_nop 7":"+v"(pA0),"+v"(pA1));CMASK(pA0,pA1,0);
  START(pA0,pA1);
  _Pragma("unroll") for(int r=0;r<16;++r)pA1[r]=__builtin_amdgcn_exp2f(pA1[r]);
  WAIT_BAR(0);
  DMA_K(3,0);DMA_V(1,SLOTB);
  ROT();
  kload8(kf,kp0+sl_cur);
  WAIT_BAR(2);
  s16x4 vlo[8],vhi[8]; u32x4 pw0,pw1,pw2,pw3;
  #define PKW(P,B) cvtpk_s(P[B],P[B+1])
  #define PAF(k) __builtin_bit_cast(bf16x8,pw##k)
  #define VFR(i) (bf16x8){vlo[i][0],vlo[i][1],vlo[i][2],vlo[i][3],vhi[i][0],vhi[i][1],vhi[i][2],vhi[i][3]}
  #define PIN(x) asm volatile("":"+v"(x))
  #define MX3(a,b,c) __builtin_fmaxf(__builtin_fmaxf((a),(b)),(c))
  #define GAPA(MF,A0,A1,A2,A3,W0,W1,PW) do{ MF; sacc+=A0; sacc+=A1; sacc+=A2; sacc+=A3; PIN(sacc); W0; W1; PIN(PW); SBAR(); }while(0)
  #define EX(v) __builtin_amdgcn_exp2f(v)
  #define GAPB(MF,X,B) do{ MF; X[B]=EX(X[B]); X[B+1]=EX(X[B+1]); X[B+2]=EX(X[B+2]); X[B+3]=EX(X[B+3]); PIN(X); SBAR(); }while(0)
  #define VRD(i) do{ vlo[i]=vtr(vp_+(((i)>>2)*4096+((i)&3)*1024)); vhi[i]=vtr(vp_+(((i)>>2)*4096+((i)&3)*1024+512)); }while(0)
  #define KRD(G,j) do{ if(G){ kload2(kf,kp0+sl_next,j); SBAR(); } }while(0)
  #define STEP(C0,C1,P0,P1,t,GK,GV,GL) do{ SBAR(); \
    const lds_cptr vp_=vp0+sl_prev; \
    VRD(0); SBAR(); float sacc=(P0[0]+P0[1]); \
    GAPA(C0=__builtin_amdgcn_mfma_f32_32x32x16_bf16(kf[0],qr[0],negm,0,0,0), P0[2],P0[3],P0[4],P0[5],     pw0[0]=PKW(P0,0), pw0[1]=PKW(P0,2), pw0); \
    VRD(4); SBAR(); GAPA(C1=__builtin_amdgcn_mfma_f32_32x32x16_bf16(kf[1],qr[0],negm,0,0,0), P0[6],P0[7],P0[8],P0[9],     pw0[2]=PKW(P0,4), pw0[3]=PKW(P0,6), pw0); \
    VRD(1); SBAR(); GAPA(C0=__builtin_amdgcn_mfma_f32_32x32x16_bf16(kf[2],qr[1],C0,0,0,0),   P0[10],P0[11],P0[12],P0[13], pw1[0]=PKW(P0,8), pw1[1]=PKW(P0,10), pw1); \
    VRD(5); SBAR(); GAPA(C1=__builtin_amdgcn_mfma_f32_32x32x16_bf16(kf[3],qr[1],C1,0,0,0),   P0[14],P0[15],P1[0],P1[1],   pw1[2]=PKW(P0,12),pw1[3]=PKW(P0,14), pw1); \
    VRD(2); SBAR(); GAPA(C0=__builtin_amdgcn_mfma_f32_32x32x16_bf16(kf[4],qr[2],C0,0,0,0),   P1[2],P1[3],P1[4],P1[5],     pw2[0]=PKW(P1,0), pw2[1]=PKW(P1,2), pw2); \
    VRD(6); SBAR(); GAPA(C1=__builtin_amdgcn_mfma_f32_32x32x16_bf16(kf[5],qr[2],C1,0,0,0),   P1[6],P1[7],P1[8],P1[9],     pw2[2]=PKW(P1,4), pw2[3]=PKW(P1,6), pw2); \
    VRD(3); SBAR(); GAPA(C0=__builtin_amdgcn_mfma_f32_32x32x16_bf16(kf[6],qr[3],C0,0,0,0),   P1[10],P1[11],P1[12],P1[13], pw3[0]=PKW(P1,8), pw3[1]=PKW(P1,10), pw3); \
    VRD(7); SBAR(); GAPA(C1=__builtin_amdgcn_mfma_f32_32x32x16_bf16(kf[7],qr[3],C1,0,0,0),   P1[14],P1[15],0.f,0.f,       pw3[2]=PKW(P1,12),pw3[3]=PKW(P1,14), pw3); \
    l_reg+=sacc; \
    if(GK){DMA_K((t)+3,sl_cur);} if(GV){DMA_V((t)+1,sl_next);} \
    CMASK(C0,C1,t); \
    { float a=MX3(C0[0],C0[1],C1[0]),b=MX3(C0[2],C0[3],C1[1]); a=MX3(a,C1[2],C1[3]); \
      _Pragma("unroll") for(int r=4;r<16;r+=4){a=MX3(a,C0[r],C0[r+1]);b=MX3(b,C0[r+2],C0[r+3]);a=MX3(a,C1[r],C1[r+1]);b=MX3(b,C1[r+2],C1[r+3]);} \
      float rm=__builtin_fmaxf(a,b); { auto rr=__builtin_amdgcn_permlane32_swap(__float_as_uint(rm),__float_as_uint(rm),false,false); rm=__builtin_fmaxf(__uint_as_float(rr[0]),__uint_as_float(rr[1])); } \
      resc=false; \
      if(__builtin_expect(__any(rm>(float)THRL),0)){ const float dl=__builtin_fmaxf(rm,0.f); mhat+=dl; \
        _Pragma("unroll") for(int r=0;r<16;++r){C0[r]-=dl;C1[r]-=dl;} \
        _Pragma("unroll") for(int r=0;r<16;++r)negm[r]=-mhat; asm volatile("":"+v"(negm)); \
        const float f=__builtin_amdgcn_exp2f(-dl); l_reg*=f; if(hi==0)wsf[r32]=f; resc=true; } } \
    SBAR(); \
    GAPB(o[0]=__builtin_amdgcn_mfma_f32_32x32x16_bf16(PAF(0),VFR(0),o[0],0,0,0), C0,0); \
    GAPB(o[1]=__builtin_amdgcn_mfma_f32_32x32x16_bf16(PAF(0),VFR(4),o[1],0,0,0), C0,4); \
    KRD(GL,0); GAPB(o[0]=__builtin_amdgcn_mfma_f32_32x32x16_bf16(PAF(1),VFR(1),o[0],0,0,0), C0,8); \
    KRD(GL,1); GAPB(o[1]=__builtin_amdgcn_mfma_f32_32x32x16_bf16(PAF(1),VFR(5),o[1],0,0,0), C0,12); \
    KRD(GL,2); GAPB(o[0]=__builtin_amdgcn_mfma_f32_32x32x16_bf16(PAF(2),VFR(2),o[0],0,0,0), C1,0); \
    KRD(GL,3); GAPB(o[1]=__builtin_amdgcn_mfma_f32_32x32x16_bf16(PAF(2),VFR(6),o[1],0,0,0), C1,4); \
    GAPB(o[0]=__builtin_amdgcn_mfma_f32_32x32x16_bf16(PAF(3),VFR(3),o[0],0,0,0), C1,8); \
    GAPB(o[1]=__builtin_amdgcn_mfma_f32_32x32x16_bf16(PAF(3),VFR(7),o[1],0,0,0), C1,12); \
    }while(0)
  int t=1;
  #undef CMASK
  #define CMASK(P0,P1,t) do{}while(0)
  for(;t+5<NT;t+=2){
    STEP(pB0,pB1,pA0,pA1,t,true,true,true);     WAIT_BAR(2); RESC(); ROT();
    STEP(pA0,pA1,pB0,pB1,t+1,true,true,true);   WAIT_BAR(2); RESC(); ROT();
  }
  #undef CMASK
  #define CMASK(P0,P1,t) do{}while(0)
  #define ENDW(tt) do{ if((tt)+3<NT){WAIT_BAR(2);} else if((tt)+2<NT){WAIT_BAR(1);} else {WAIT_BAR(0);} }while(0)
  for(;t+1<NT;t+=2){
    STEP(pB0,pB1,pA0,pA1,t,(t+3<NT),(t+1<NT),(t+1<NT));       ENDW(t);   RESC(); ROT();
    STEP(pA0,pA1,pB0,pB1,t+1,(t+4<NT),(t+2<NT),(t+2<NT));     ENDW(t+1); RESC(); ROT();
  }
  STEP(pB0,pB1,pA0,pA1,NT-1,false,false,false); RESC();
  { float sacc=pB0[0]+pB0[1]; _Pragma("unroll") for(int r=2;r<16;++r)sacc+=pB0[r]; _Pragma("unroll") for(int r=0;r<16;++r)sacc+=pB1[r]; l_reg+=sacc;
    pw0=(u32x4){PKW(pB0,0),PKW(pB0,2),PKW(pB0,4),PKW(pB0,6)};pw1=(u32x4){PKW(pB0,8),PKW(pB0,10),PKW(pB0,12),PKW(pB0,14)};pw2=(u32x4){PKW(pB1,0),PKW(pB1,2),PKW(pB1,4),PKW(pB1,6)};pw3=(u32x4){PKW(pB1,8),PKW(pB1,10),PKW(pB1,12),PKW(pB1,14)};
    SBAR(); pv(o,vb0+sl_cur,PAF(0),PAF(1),PAF(2),PAF(3)); }
  #undef PKW
  #undef PAF
  #undef VFR
  #undef PIN
  #undef MX3
  #undef GAPA
  #undef GAPB
  #undef EX
  #undef VRD
  #undef KRD
  #undef STEP
  #undef ENDW
  {auto rr=__builtin_amdgcn_permlane32_swap(__float_as_uint(l_reg),__float_as_uint(l_reg),false,false);l_reg=__uint_as_float(rr[0])+__uint_as_float(rr[1]);}
  if(hi==0)wsf[32+r32]=l_reg;asm volatile("s_waitcnt lgkmcnt(0)":::"memory");
  float rli[16];
  #pragma unroll
  for(int r=0;r<16;++r)rli[r]=__builtin_amdgcn_rcpf(wsf[32+crow(r,hi)]);
  bf16*Ow=Qw;
  { bf16*stg=(bf16*)(shm+LDS_OST)+wid*2048;
    #pragma unroll
    for(int r=0;r<16;++r){const int orow=crow(r,hi);
      #pragma unroll
      for(int d0=0;d0<2;++d0)stg[orow*64+d0*32+r32]=__float2bfloat16(o[d0][r]*rli[r]);}
    asm volatile("s_waitcnt lgkmcnt(0)":::"memory");
    #pragma unroll
    for(int i=0;i<4;++i){const int row=i*8+(lane>>3),ch=lane&7; const u32x4 v=*(const u32x4*)(stg+row*64+ch*8);
      const u32x4 z=*(const u32x4*)(Ow+(long)row*DM+512+ch*8);
      u32x4 w; float sq=0.f;
      #pragma unroll
      for(int k=0;k<4;++k){ const float o0=__uint_as_float(v[k]<<16),o1=__uint_as_float(v[k]&0xffff0000u),z0=__uint_as_float(z[k]<<16),z1=__uint_as_float(z[k]&0xffff0000u);
        const float y0=o0*z0*__builtin_amdgcn_rcpf(1.f+__expf(-z0)),y1=o1*z1*__builtin_amdgcn_rcpf(1.f+__expf(-z1)); const unsigned pk=cvtpk_s(y0,y1); w[k]=pk;
        const float r0=__uint_as_float(pk<<16),r1=__uint_as_float(pk&0xffff0000u); sq+=r0*r0+r1*r1; }
      ATTN_STORE16(Ow+(long)row*DM+ch*8,w);
      sq+=__shfl_xor(sq,1);sq+=__shfl_xor(sq,2);sq+=__shfl_xor(sq,4);
      if(ch==0)ssq[(rowbase+q0+wid*QBLK+row)*16+6+h]=sq; } }
  asm volatile("s_waitcnt lgkmcnt(0)\n\ts_barrier":::"memory");
  #undef DMA_K
  #undef DMA_V
  #undef CMASK
  #undef START
  #undef RESC
  #undef ROT
}
#undef SBAR
#undef WAIT_BAR
}
namespace wa {
typedef unsigned short bf16_t;
using bf16x8 = __attribute__((ext_vector_type(8))) short;
using s16x4 = __attribute__((ext_vector_type(4))) short;
using f32x16 = __attribute__((ext_vector_type(16))) float;
using u32x4 = __attribute__((ext_vector_type(4))) unsigned;
using u32x2 = __attribute__((ext_vector_type(2))) unsigned;
typedef __attribute__((address_space(3))) const char* lds_cptr;
typedef __attribute__((address_space(3))) char* lds_ptr;
typedef short v4i16_t __attribute__((ext_vector_type(4)));
constexpr int INW = 3840;
__device__ __forceinline__ int crow(int r, int hi) { return (r & 3) + 8 * (r >> 2) + 4 * hi; }
__device__ __forceinline__ s16x4 vtr(lds_cptr p) { return __builtin_bit_cast(s16x4, __builtin_amdgcn_ds_read_tr16_b64_v4i16((__attribute__((address_space(3))) v4i16_t*)p)); }
typedef float f32x2_t __attribute__((ext_vector_type(2))); typedef __bf16 bf16x2_t __attribute__((ext_vector_type(2)));
__device__ __forceinline__ unsigned cvtpk(float lo, float hi) { f32x2_t v = {lo, hi}; bf16x2_t b = __builtin_convertvector(v, bf16x2_t); return __builtin_bit_cast(unsigned, b); }
__device__ __forceinline__ float xhalf_max(float m) { auto rr = __builtin_amdgcn_permlane32_swap(__float_as_uint(m), __float_as_uint(m), false, false); return fmaxf(__uint_as_float(rr[0]), __uint_as_float(rr[1])); }
__device__ __forceinline__ float xhalf_sum(float m) { auto rr = __builtin_amdgcn_permlane32_swap(__float_as_uint(m), __float_as_uint(m), false, false); return __uint_as_float(rr[0]) + __uint_as_float(rr[1]); }
__device__ __forceinline__ float bflo(unsigned w) { return __uint_as_float(w << 16); }
__device__ __forceinline__ float bfhi(unsigned w) { return __uint_as_float(w & 0xffff0000u); }
__device__ __forceinline__ float silu(float z) { return z * __builtin_amdgcn_rcpf(1.f + __expf(-z)); }

struct St { f32x16 o0, o1; float m, l; };
__device__ __forceinline__ void st_init(St& s) { s.o0 = f32x16{}; s.o1 = f32x16{}; s.m = -1e30f; s.l = 0.f; }

template <int MODE>
__device__ __forceinline__ void tile(St& st, const bf16x8 (&qr)[4], lds_cptr kt, lds_cptr vt, int lane, int clo, const __attribute__((address_space(3))) float* bl) {
    const int r32 = lane & 31, hi = lane >> 5;
    f32x16 s = f32x16{};
    { const lds_cptr kp = kt + hi * 512 + r32 * 16;
#pragma unroll
      for (int d0 = 0; d0 < 4; ++d0) { const bf16x8 kf = *(const __attribute__((address_space(3))) bf16x8*)(kp + d0 * 1024); s = __builtin_amdgcn_mfma_f32_32x32x16_bf16(kf, qr[d0], s, 0, 0, 0); } }
    float tm = -INFINITY;
#pragma unroll
    for (int r = 0; r < 16; ++r) { const int a = (r & 3) + 8 * (r >> 2) + 4 * hi;
        if (MODE == 1) { if (a < r32) s[r] = -INFINITY; }
        if (MODE == 2) { if (a > r32) s[r] = -INFINITY; }
        if (MODE == 3) { const float b = bl[(r & 3) + 8 * (r >> 2)]; s[r] = ((unsigned)(a - clo) < 16u) ? s[r] + b : -INFINITY; }
        tm = fmaxf(tm, s[r]); }
    tm = xhalf_max(tm);
    const float mn = fmaxf(st.m, tm), alpha = __builtin_amdgcn_exp2f(st.m - mn); st.m = mn;
    float ps = 0.f;
#pragma unroll
    for (int r = 0; r < 16; ++r) { s[r] = __builtin_amdgcn_exp2f(s[r] - mn); ps += s[r]; }
    st.l = st.l * alpha + ps;
    st.o0 *= alpha; st.o1 *= alpha;
    u32x4 pw0, pw1;
    pw0[0] = cvtpk(s[0], s[1]); pw0[1] = cvtpk(s[2], s[3]); pw0[2] = cvtpk(s[4], s[5]); pw0[3] = cvtpk(s[6], s[7]);
    pw1[0] = cvtpk(s[8], s[9]); pw1[1] = cvtpk(s[10], s[11]); pw1[2] = cvtpk(s[12], s[13]); pw1[3] = cvtpk(s[14], s[15]);
    const lds_cptr vp = vt + ((lane >> 4) & 1) * 32 + (lane & 3) * 8 + (4 * hi + ((lane & 15) >> 2)) * 64;
#define WA_VF(ks, d0) ({ const s16x4 lo_ = vtr(vp + (d0) * 2048 + (ks) * 1024), hi_ = vtr(vp + (d0) * 2048 + (ks) * 1024 + 512); (bf16x8){lo_[0], lo_[1], lo_[2], lo_[3], hi_[0], hi_[1], hi_[2], hi_[3]}; })
    st.o0 = __builtin_amdgcn_mfma_f32_32x32x16_bf16(WA_VF(0, 0), __builtin_bit_cast(bf16x8, pw0), st.o0, 0, 0, 0);
    st.o1 = __builtin_amdgcn_mfma_f32_32x32x16_bf16(WA_VF(0, 1), __builtin_bit_cast(bf16x8, pw0), st.o1, 0, 0, 0);
    st.o0 = __builtin_amdgcn_mfma_f32_32x32x16_bf16(WA_VF(1, 0), __builtin_bit_cast(bf16x8, pw1), st.o0, 0, 0, 0);
    st.o1 = __builtin_amdgcn_mfma_f32_32x32x16_bf16(WA_VF(1, 1), __builtin_bit_cast(bf16x8, pw1), st.o1, 0, 0, 0);
#undef WA_VF
}

__device__ __forceinline__ void put_kv(lds_ptr ring, int voff, int slot, int rr, int c, u32x4 k, u32x4 v) {
    *(__attribute__((address_space(3))) u32x4*)(ring + slot * 4096 + c * 512 + rr * 16) = k;
    *(__attribute__((address_space(3))) u32x4*)(ring + voff + slot * 4096 + (c >> 2) * 2048 + rr * 64 + (c & 3) * 16) = v;
}

constexpr int A_VOFF = 49152;
__device__ __forceinline__ void a_unit(long base, int S, int h, int pat, int u, bf16_t* proj, bf16_t* OP, float* LSE, float* ssq, lds_ptr ring) {
    const int tid = tidx(), lane = tid & 63, r32 = lane & 31, hi = lane >> 5; const int wid = __builtin_amdgcn_readfirstlane(tid >> 6);
    const int dsh = 2 * pat, dil = 1 << dsh, L = S >> dsh;
    const bool two = (L == 128);
    const int nblk = two ? 1 : (L >> 8);
    const int rho0 = two ? 2 * u : u / nblk, j0 = two ? 0 : 256 * (u % nblk);
    const int SPS = two ? 4 : 12, ktlo = two ? 2 : 0, nslot = two ? 8 : 12;
    { const bf16_t* kb = proj + 384 + h * 64; const bf16_t* vb = proj + 768 + h * 64;
      for (int i0 = 0; i0 < nslot * 256; i0 += 512 * 3) {
          u32x4 kk[3], vv[3]; int ok[3];
#pragma unroll
          for (int i = 0; i < 3; ++i) { const int idx = i0 + i * 512 + tid; const int rowi = idx >> 3, c = idx & 7, slot = rowi >> 5, rr = rowi & 31, seg = slot / SPS, kt = slot % SPS + ktlo;
              const int j = j0 - 64 + 32 * kt + rr; ok[i] = (idx < nslot * 256) && j >= 0 && j < L;
              if (ok[i]) { const size_t g = (size_t)(base + (long)j * dil + rho0 + seg) * INW + c * 8; kk[i] = *(const u32x4*)(kb + g); vv[i] = *(const u32x4*)(vb + g); } }
#pragma unroll
          for (int i = 0; i < 3; ++i) { const int idx = i0 + i * 512 + tid; const int rowi = idx >> 3, c = idx & 7, slot = rowi >> 5, rr = rowi & 31; if (ok[i]) put_kv(ring, A_VOFF, slot, rr, c, kk[i], vv[i]); }
      } }
    __syncthreads();
    const int wps = two ? 4 : 8, seg = wid / wps, qi = wid % wps;
    const int jq = j0 + 32 * qi + r32; const long qrow = base + (long)jq * dil + rho0 + seg;
    bf16_t* qp = proj + (size_t)qrow * INW + h * 64;
    bf16x8 qr[4];
#pragma unroll
    for (int d0 = 0; d0 < 4; ++d0) qr[d0] = *(const bf16x8*)(qp + d0 * 16 + hi * 8);
    St st; st_init(st);
#pragma unroll
    for (int dk = 0; dk < 5; ++dk) { const int kt = qi + dk, jt = j0 - 64 + 32 * kt; if (jt < 0 || jt >= L) continue;
        const int slot = seg * SPS + kt - ktlo; const lds_cptr ktp = (lds_cptr)ring + slot * 4096, vtp = (lds_cptr)ring + A_VOFF + slot * 4096;
        if (dk == 0) tile<1>(st, qr, ktp, vtp, lane, 0, nullptr); else if (dk == 4) tile<2>(st, qr, ktp, vtp, lane, 0, nullptr); else tile<0>(st, qr, ktp, vtp, lane, 0, nullptr); }
    const float lt = xhalf_sum(st.l), il = __builtin_amdgcn_rcpf(lt), lse = st.m + __builtin_amdgcn_logf(lt);
    if (pat < 2) {
        bf16_t* op = OP + ((size_t)pat * 49152 + qrow) * 384 + h * 64 + 4 * hi;
#pragma unroll
        for (int g = 0; g < 4; ++g) { u32x2 w0, w1; w0[0] = cvtpk(st.o0[4 * g] * il, st.o0[4 * g + 1] * il); w0[1] = cvtpk(st.o0[4 * g + 2] * il, st.o0[4 * g + 3] * il);
            w1[0] = cvtpk(st.o1[4 * g] * il, st.o1[4 * g + 1] * il); w1[1] = cvtpk(st.o1[4 * g + 2] * il, st.o1[4 * g + 3] * il);
            *(u32x2*)(op + 8 * g) = w0; *(u32x2*)(op + 32 + 8 * g) = w1; }
        if (hi == 0) LSE[((size_t)pat * 49152 + qrow) * 8 + h] = lse;
    } else {
        const float l0 = LSE[((size_t)0 * 49152 + qrow) * 8 + h], l1 = LSE[((size_t)1 * 49152 + qrow) * 8 + h];
        const float M = fmaxf(fmaxf(l0, l1), lse); const float e0 = __builtin_amdgcn_exp2f(l0 - M), e1 = __builtin_amdgcn_exp2f(l1 - M), e2 = __builtin_amdgcn_exp2f(lse - M);
        const float inv = __builtin_amdgcn_rcpf(e0 + e1 + e2), w0 = e0 * inv, w1 = e1 * inv, w2 = e2 * inv * il;
        const bf16_t* op0 = OP + ((size_t)0 * 49152 + qrow) * 384 + h * 64 + 4 * hi; const bf16_t* op1 = OP + ((size_t)1 * 49152 + qrow) * 384 + h * 64 + 4 * hi;
        const bf16_t* zp = qp + 1152 + 4 * hi; bf16_t* yp = qp + 4 * hi; float sq = 0.f;
#pragma unroll
        for (int half = 0; half < 2; ++half)
#pragma unroll
            for (int g = 0; g < 4; ++g) { const int off = 32 * half + 8 * g; const u32x2 a = *(const u32x2*)(op0 + off), b = *(const u32x2*)(op1 + off), z = *(const u32x2*)(zp + off);
                const f32x16& oo = half ? st.o1 : st.o0; u32x2 y;
#pragma unroll
                for (int k = 0; k < 2; ++k) { const float y0 = (w0 * bflo(a[k]) + w1 * bflo(b[k]) + w2 * oo[4 * g + 2 * k]) * silu(bflo(z[k])), y1 = (w0 * bfhi(a[k]) + w1 * bfhi(b[k]) + w2 * oo[4 * g + 2 * k + 1]) * silu(bfhi(z[k]));
                    const unsigned pk = cvtpk(y0, y1); y[k] = pk; const float r0 = bflo(pk), r1 = bfhi(pk); sq += r0 * r0 + r1 * r1; }
                *(u32x2*)(yp + off) = y; }
        sq = xhalf_sum(sq);
        if (hi == 0) ssq[(size_t)qrow * 16 + h] = sq;
    }
    __syncthreads();
}

constexpr int C_BIAS_OFF = 65536;
__device__ __forceinline__ void c_unit(long base, int S, int h, int gr0, bf16_t* proj, const float* relb, float* ssq, lds_ptr ring) {
    const int tid = tidx(), lane = tid & 63, r32 = lane & 31, hi = lane >> 5; const int wid = __builtin_amdgcn_readfirstlane(tid >> 6);
    const int R = S >> 6;
    __attribute__((address_space(3))) float* bias = (__attribute__((address_space(3))) float*)(ring + C_BIAS_OFF) + 64;
    if (tid < 465) bias[tid] = relb[h * 465 + tid] * 1.4426950408889634f;
    const int gr = gr0 + (wid >> 1), qc = 32 * (wid & 1) + r32;
    int rs = gr - 4; rs = rs < 0 ? 0 : (rs > R - 8 ? R - 8 : rs);
    int cs = qc - 8; cs = cs < 0 ? 0 : (cs > 48 ? 48 : cs);
    int klo = gr0 - 4; klo = klo < 0 ? 0 : (klo > R - 8 ? R - 8 : klo);
    int khi = gr0 + 3 - 4; khi = khi < 0 ? 0 : (khi > R - 8 ? R - 8 : khi); khi += 8;
    const long qrow = base + gr * 64 + qc;
    bf16_t* qp = proj + (size_t)qrow * INW + 2304 + h * 64;
    bf16x8 qr[4];
#pragma unroll
    for (int d0 = 0; d0 < 4; ++d0) qr[d0] = *(const bf16x8*)(qp + d0 * 16 + hi * 8);
    St st; st_init(st);
    const bf16_t* kb = proj + 2688 + h * 64; const bf16_t* vb = proj + 3072 + h * 64;
    const int skc = tid >> 3, sc = tid & 7;
    u32x4 kk, vv;
    { const size_t g = (size_t)(base + klo * 64 + skc) * INW + sc * 8; kk = *(const u32x4*)(kb + g); vv = *(const u32x4*)(vb + g); }
    { lds_ptr bp = ring; *(__attribute__((address_space(3))) u32x4*)(bp + (skc >> 5) * 4096 + sc * 512 + (skc & 31) * 16) = kk;
      *(__attribute__((address_space(3))) u32x4*)(bp + 8192 + (skc >> 5) * 4096 + (sc >> 2) * 2048 + (skc & 31) * 64 + (sc & 3) * 16) = vv; }
    __syncthreads();
    int cur = 0;
    for (int kr = klo; kr < khi; ++kr) {
        const bool more = kr + 1 < khi;
        if (more) { const size_t g = (size_t)(base + (kr + 1) * 64 + skc) * INW + sc * 8; kk = *(const u32x4*)(kb + g); vv = *(const u32x4*)(vb + g); }
        if (kr >= rs && kr < rs + 8) {
            const __attribute__((address_space(3))) float* brow = bias + (kr - gr + 7) * 31 + 15 - qc + 4 * hi;
            const lds_cptr bp = (lds_cptr)ring + cur * 16384;
            tile<3>(st, qr, bp, bp + 8192, lane, cs, brow);
            tile<3>(st, qr, bp + 4096, bp + 8192 + 4096, lane, cs - 32, brow + 32);
        }
        if (more) { lds_ptr bp = ring + (cur ^ 1) * 16384; *(__attribute__((address_space(3))) u32x4*)(bp + (skc >> 5) * 4096 + sc * 512 + (skc & 31) * 16) = kk;
            *(__attribute__((address_space(3))) u32x4*)(bp + 8192 + (skc >> 5) * 4096 + (sc >> 2) * 2048 + (skc & 31) * 64 + (sc & 3) * 16) = vv; }
        __syncthreads(); cur ^= 1;
    }
    const float lt = xhalf_sum(st.l), il = __builtin_amdgcn_rcpf(lt);
    const bf16_t* zp = qp + 1152 + 4 * hi; bf16_t* yp = qp + 4 * hi; float sq = 0.f;
#pragma unroll
    for (int half = 0; half < 2; ++half)
#pragma unroll
        for (int g = 0; g < 4; ++g) { const int off = 32 * half + 8 * g; const u32x2 z = *(const u32x2*)(zp + off); const f32x16& oo = half ? st.o1 : st.o0; u32x2 y;
#pragma unroll
            for (int k = 0; k < 2; ++k) { const float y0 = oo[4 * g + 2 * k] * il * silu(bflo(z[k])), y1 = oo[4 * g + 2 * k + 1] * il * silu(bfhi(z[k]));
                const unsigned pk = cvtpk(y0, y1); y[k] = pk; const float r0 = bflo(pk), r1 = bfhi(pk); sq += r0 * r0 + r1 * r1; }
            *(u32x2*)(yp + off) = y; }
    sq = xhalf_sum(sq);
    if (hi == 0) ssq[(size_t)qrow * 16 + 10 + h] = sq;
    __syncthreads();
}
}
constexpr int NWAVES = 8;
constexpr int NTOK = 49152, NPROW = 16384, DMODEL = 1024, INW = 3840;
constexpr size_t MiB = 1u << 20;
constexpr size_t WS_CTL = 0, CTL_ZERO_BYTES = 64 * 1024;
constexpr size_t WS_WIN = 1 * MiB;
constexpr size_t WS_WOUT = 16 * MiB;
constexpr size_t WS_TABA = 20 * MiB, WS_TABR = WS_TABA + 8192 * 16 * 4, WS_TABC = WS_TABR + 128 * 32 * 4;
constexpr size_t WS_RPRE = 21 * MiB;
constexpr size_t WS_SSQ = 22 * MiB, WS_SSQ2 = 26 * MiB;
constexpr size_t WS_LSE = 30 * MiB;
constexpr size_t WS_PROJ = 34 * MiB;
constexpr size_t WS_U = WS_PROJ + (size_t)NTOK * INW * 2;
constexpr size_t WS_END = WS_U + (size_t)NTOK * DMODEL * 2;
static_assert((size_t)2 * NTOK * 384 * 2 <= (size_t)NTOK * DMODEL * 2, "OP fits in U");
constexpr int RING_BYTES = 131072, LDSCTL_OFF = RING_BYTES + 8192, MISC_OFF = LDSCTL_OFF + 320, LDS_BYTES = 147456;

#define GAS __attribute__((address_space(1)))
#define LAS __attribute__((address_space(3)))
typedef unsigned short bf16;
typedef unsigned v4u __attribute__((ext_vector_type(4)));
typedef float f32x4 __attribute__((ext_vector_type(4)));
typedef GAS unsigned gu32;
#define LDS_WAIT() asm volatile("s_waitcnt lgkmcnt(0)" ::: "memory")
__device__ __forceinline__ unsigned f2bf(float f) { unsigned u = __builtin_bit_cast(unsigned, f); return (u + 0x7fffu + ((u >> 16) & 1u)) >> 16; }
__device__ __forceinline__ unsigned pk2(float lo, float hi) { return f2bf(lo) | (f2bf(hi) << 16); }

#define XB_TMO      128
#define XB_XCNT(j)  (256  + 64 * (j))
#define XB_XSUB(j)  (1280 + 64 * (j))
#define XB_XGEN(j)  (2304 + 64 * (j))
#define XB_TOP      3328
#define XB_TOPGEN   3392
#define XCD_BAR_WORDS 3456
#define XB_SPIN_CAP (1u << 22)
__device__ __forceinline__ unsigned xb_ld(unsigned* p)              { return __hip_atomic_load(p, __ATOMIC_RELAXED, __HIP_MEMORY_SCOPE_AGENT); }
__device__ __forceinline__ unsigned xb_add(unsigned* p, unsigned v) { return __hip_atomic_fetch_add(p, v, __ATOMIC_RELAXED, __HIP_MEMORY_SCOPE_AGENT); }
__device__ __forceinline__ unsigned xb_xcc_id() { return (unsigned)__builtin_amdgcn_s_getreg((3 << 11) | 20) & 0xFu; }
#define XB_SPIN(cond, bar) do { unsigned _sp = 0; while (cond) { __builtin_amdgcn_s_sleep(1); \
    if ((++_sp & 255u) == 0u) { if (xb_ld(&(bar)[XB_TMO])) break; if (_sp > XB_SPIN_CAP) { atomicAdd(&(bar)[XB_TMO], 1u); break; } } } } while (0)
struct XcdBarrier { unsigned* bar; unsigned x; volatile LAS unsigned* st; };
__device__ __forceinline__ XcdBarrier xcd_barrier_post(unsigned* bar, volatile LAS unsigned* st) {
    XcdBarrier b; b.bar = bar; b.x = xb_xcc_id(); b.st = st;
    if (threadIdx.x == 0) (void)xb_add(&bar[XB_XCNT(b.x)], 1u);
    return b;
}
__device__ __forceinline__ void xcd_barrier_complete(unsigned* bar, unsigned x, unsigned& nloc, unsigned& nx) {
    const unsigned G = gridDim.x * gridDim.y * gridDim.z;
    unsigned sum, cnt, mine, sp = 0u;
    for (;;) {
        sum = 0u; cnt = 0u; mine = 0u;
#pragma unroll
        for (unsigned j = 0; j < 16; ++j) { const unsigned c = xb_ld(&bar[XB_XCNT(j)]); sum += c; cnt += (c > 0u) ? 1u : 0u; mine = (j == x) ? c : mine; }
        if (sum == G) break;
        __builtin_amdgcn_s_sleep(1);
        if ((++sp & 255u) == 0u) { if (xb_ld(&bar[XB_TMO])) break; if (sp > XB_SPIN_CAP) { atomicAdd(&bar[XB_TMO], 1u); break; } }
    }
    nloc = mine > 0u ? mine : 1u; nx = cnt > 0u ? cnt : 1u;
}
__device__ __forceinline__ void xcd_barrier(const XcdBarrier& b) {
    asm volatile("s_waitcnt vmcnt(0)" ::: "memory");
    __syncthreads();
    if (threadIdx.x == 0) {
        unsigned* bar = b.bar;
        __builtin_amdgcn_s_waitcnt(0);
        unsigned nloc = b.st[0], nx = b.st[1];
        if (nloc == 0u) { xcd_barrier_complete(bar, b.x, nloc, nx); b.st[0] = nloc; b.st[1] = nx; }
        const unsigned old = xb_add(&bar[XB_XSUB(b.x)], 1u);
        const unsigned gen = old / nloc;
        if (old + 1u == (gen + 1u) * nloc) {
            __builtin_amdgcn_fence(__ATOMIC_RELEASE, "agent");
            asm volatile("s_waitcnt vmcnt(0)" ::: "memory");
            const unsigned og = xb_add(&bar[XB_TOP], 1u);
            const unsigned tg = og / nx;
            if (og + 1u == (tg + 1u) * nx) xb_add(&bar[XB_TOPGEN], 1u);
            else XB_SPIN(xb_ld(&bar[XB_TOPGEN]) == tg, bar);
            __builtin_amdgcn_fence(__ATOMIC_ACQUIRE, "agent");
            xb_add(&bar[XB_XGEN(b.x)], 1u);
            asm volatile("s_waitcnt vmcnt(0)" ::: "memory");
        } else {
            XB_SPIN(xb_ld(&bar[XB_XGEN(b.x)]) == gen, bar);
            __builtin_amdgcn_fence(__ATOMIC_ACQUIRE, "agent");
            asm volatile("s_waitcnt vmcnt(0)" ::: "memory");
        }
    }
    __syncthreads();
}

__device__ __forceinline__ float wave_sum(float v) {
#pragma unroll
    for (int o = 1; o < 64; o <<= 1) v += __shfl_xor(v, o);
    return v;
}
__host__ __device__ __forceinline__ int phys2log(int n) { return (n & ~255) + 64 * ((n >> 5) & 3) + 32 * ((n >> 7) & 1) + (n & 31); }
template <bool PERMUTE>
__device__ __forceinline__ void p0_transpose_item(const float* W, const float* gain, int K, int N, bf16* WT, LAS float* scr, int item, int lane) {
    const int nblk = N / 32, kb = item / nblk, nb = item % nblk, k0 = 64 * kb, n0 = 32 * nb, l0 = PERMUTE ? phys2log(n0) : n0;
#pragma unroll 8
    for (int i = 0; i < 32; ++i) { const int kk = 2 * i + (lane >> 5); scr[kk * 33 + (lane & 31)] = W[(size_t)(k0 + kk) * N + l0 + (lane & 31)] * gain[k0 + kk]; }
    LDS_WAIT(); asm volatile("" ::: "memory");
    const int c = lane & 7;
#pragma unroll
    for (int j = 0; j < 4; ++j) { const int n = (lane >> 3) + 8 * j; const LAS float* s = scr + (8 * c) * 33 + n;
        v4u o; o.x = pk2(s[0 * 33], s[1 * 33]); o.y = pk2(s[2 * 33], s[3 * 33]); o.z = pk2(s[4 * 33], s[5 * 33]); o.w = pk2(s[6 * 33], s[7 * 33]);
        *(GAS v4u*)(WT + (size_t)(n0 + n) * K + k0 + 8 * c) = o; }
    LDS_WAIT(); asm volatile("" ::: "memory");
}
__device__ __forceinline__ void prep_row(const float* xrow, bf16* orow, float* rp, int lane) {
    const GAS f32x4* xr = (const GAS f32x4*)xrow + lane;
    f32x4 v[4]; float s = 0.f;
#pragma unroll
    for (int j = 0; j < 4; ++j) { v[j] = xr[64 * j]; s += (v[j].x * v[j].x + v[j].y * v[j].y) + (v[j].z * v[j].z + v[j].w * v[j].w); }
    s = wave_sum(s);
    if (lane == 0) *rp = rsqrtf(s * (1.f / 1024.f) + 1e-6f);
    GAS unsigned long long* o8 = (GAS unsigned long long*)orow + lane;
#pragma unroll
    for (int j = 0; j < 4; ++j) o8[64 * j] = (unsigned long long)pk2(v[j].x, v[j].y) | ((unsigned long long)pk2(v[j].z, v[j].w) << 32);
}
__device__ __forceinline__ void finish_row(const float* xrow, float* orow, bf16* urow, const float* s2, const float* gpost, float* rp, int lane) {
    const f32x4* s4 = (const f32x4*)s2; const f32x4 a = s4[0], b = s4[1], c = s4[2], d = s4[3];
    const float tot = ((a.x + a.y) + (a.z + a.w)) + ((b.x + b.y) + (b.z + b.w)) + ((c.x + c.y) + (c.z + c.w)) + ((d.x + d.y) + (d.z + d.w));
    const float r = rsqrtf(tot * (1.f / 1024.f) + 1e-6f);
    const GAS f32x4* xr = (const GAS f32x4*)xrow + lane; const GAS f32x4* gr = (const GAS f32x4*)gpost + lane; GAS f32x4* orr = (GAS f32x4*)orow + lane;
    GAS unsigned long long* u8 = (GAS unsigned long long*)urow + lane;
    float s = 0.f;
#pragma unroll
    for (int j = 0; j < 4; ++j) { const f32x4 x = xr[64 * j], g = gr[64 * j]; const unsigned long long w = u8[64 * j]; const unsigned w0 = (unsigned)w, w1 = (unsigned)(w >> 32);
        f32x4 n; n.x = x.x + __uint_as_float(w0 << 16) * r * g.x; n.y = x.y + __uint_as_float(w0 & 0xffff0000u) * r * g.y; n.z = x.z + __uint_as_float(w1 << 16) * r * g.z; n.w = x.w + __uint_as_float(w1 & 0xffff0000u) * r * g.w;
        orr[64 * j] = n; s += (n.x * n.x + n.y * n.y) + (n.z * n.z + n.w * n.w);
        u8[64 * j] = (unsigned long long)pk2(n.x, n.y) | ((unsigned long long)pk2(n.z, n.w) << 32); }
    s = wave_sum(s);
    if (lane == 0) *rp = rsqrtf(s * (1.f / 1024.f) + 1e-6f);
}

#ifdef NO_G1
#define RUN_G1(...)
#else
#define RUN_G1(...) __VA_ARGS__
#endif
#ifdef NO_G2
#define RUN_G2(...)
#else
#define RUN_G2(...) __VA_ARGS__
#endif
#ifdef NO_B
#define RUN_B(...)
#else
#define RUN_B(...) __VA_ARGS__
#endif
#ifdef NO_A
#define RUN_A(...)
#else
#define RUN_A(...) __VA_ARGS__
#endif
#ifdef NO_C
#define RUN_C(...)
#else
#define RUN_C(...) __VA_ARGS__
#endif
#ifdef NO_TAB
#define RUN_TAB 0
#else
#define RUN_TAB 1
#endif
struct Args { const float* in[10]; float* out; unsigned char* ws; int ph_lo, ph_hi, amask, pad; };
constexpr int N_PHASES = 11;
__global__ void __launch_bounds__(NWAVES * 64, 2) mk_fwd(Args args) {
    extern __shared__ __attribute__((aligned(16))) unsigned char lds[];
    LAS unsigned char* L = (LAS unsigned char*)lds;
    const int G = gridDim.x; const int bx = blockIdx.x; const int vcu = (G % 8 == 0) ? (bx % 8) * (G / 8) + bx / 8 : bx;
    for (int u = threadIdx.x; u < (LDS_BYTES - LDSCTL_OFF) / 4; u += NWAVES * 64) ((LAS unsigned*)(L + LDSCTL_OFF))[u] = 0u;
    __syncthreads();
    volatile LAS unsigned* MISC = (volatile LAS unsigned*)(L + MISC_OFF);
    XcdBarrier bar = xcd_barrier_post((unsigned*)(args.ws + WS_CTL), MISC + 8);
    const int lo = args.ph_lo, hi = args.ph_hi;
    for (int ph = lo; ph < hi; ++ph) {
        const int tid = tidx(), lane = tid & 63, wave = __builtin_amdgcn_readfirstlane(tid >> 6);
        const int gw = vcu * NWAVES + wave, NGW = G * NWAVES;
        unsigned char* ws = opaque_s(args.ws);
        const float* xp = args.in[0]; const float* xs = args.in[1]; const float* norm_pre = args.in[2]; const float* w_in = args.in[3]; const float* q_norm = args.in[4]; const float* k_norm = args.in[5];
        const float* rel_bias = args.in[6]; const float* branch_gain = args.in[7]; const float* w_out = args.in[8]; const float* norm_post = args.in[9];
        bf16* WIN = (bf16*)(ws + WS_WIN); bf16* WOUT = (bf16*)(ws + WS_WOUT); float* tabA = (float*)(ws + WS_TABA); float* tabR = (float*)(ws + WS_TABR); float* tabC = (float*)(ws + WS_TABC);
        float* rpre = (float*)(ws + WS_RPRE); float* ssq = (float*)(ws + WS_SSQ); float* ssq2 = (float*)(ws + WS_SSQ2); float* LSE = (float*)(ws + WS_LSE);
        bf16* proj = (bf16*)(ws + WS_PROJ); bf16* U = (bf16*)(ws + WS_U);
        if (ph == 0) {
            LAS float* scr = (LAS float*)(L + wave * 16384);
            constexpr int I_IN = 16 * 120, I_OUT = 16 * 32;
            for (int it = gw; it < 2 * (I_IN + I_OUT); it += NGW) { int r = it; const int l = r / (I_IN + I_OUT); r -= l * (I_IN + I_OUT);
                if (r < I_IN) p0_transpose_item<true>(w_in + (size_t)l * 1024 * 3840, norm_pre + l * 1024, 1024, 3840, WIN + (size_t)l * 3840 * 1024, scr, r, lane);
                else p0_transpose_item<false>(w_out + (size_t)l * 1024 * 1024, branch_gain + l * 1024, 1024, 1024, WOUT + (size_t)l * 1024 * 1024, scr, r - I_IN, lane); }
            { const int i = bx * (NWAVES * 64) + tid;
              if (RUN_TAB && i < 8192 * 8) { const int t = i >> 3, j = i & 7; const float a = (float)t * exp2f(-(float)j * (18.931568569324174f / 8.0f)); tabA[t * 16 + j] = cosf(a); tabA[t * 16 + 8 + j] = sinf(a); }
              if (RUN_TAB && i < 128 * 16) { const int t = i >> 4, j = i & 15; const float a = (float)t * exp2f(-(float)j * (13.287712379549449f / 16.0f)); const float c = cosf(a), sn = sinf(a); tabR[t * 32 + j] = c; tabR[t * 32 + 16 + j] = sn;
                  if (t < 64) { tabC[t * 32 + j] = c; tabC[t * 32 + 16 + j] = sn; } } }
            for (int m = gw; m < NTOK; m += NGW) prep_row(m < NPROW ? xp + (size_t)m * 1024 : xs + (size_t)(m - NPROW) * 1024, U + (size_t)m * 1024, rpre + m, lane);
        } else {
            const int l = (ph - 1) / 5, sub = (ph - 1) % 5;
            if (sub == 0) {
                pg8::Gemm g{U, WIN + (size_t)l * 3840 * 1024, NTOK, 3840, 1024, 1024}; pg8::StaticOrder S; S.init(NTOK, 3840, G, bx);
                pg8::EpiProj E{proj, rpre, q_norm + l * 64, k_norm + l * 64, tabA, tabR, tabC};
                RUN_G1(pg8::gemm_phase<pg8::EpiProj, pg8::StaticOrder, pg8::AMapLin, true, true>(L, g, S, E));
            } else if (sub == 1) {
                if (args.amask & 1) { const int x = vcu >> 5, s = vcu & 31;
                  RUN_B(attn_body::attn_unit<8>((long)(x >> 2) * 8192, 8192, 2 * ((x >> 1) & 1) + (x & 1), s, (attn_body::bf16*)proj, ssq, (char*)lds));
                  for (int j = 0; j < 2; ++j) { const int uid = 2 * s + j, seq = 2 * x + (uid >> 5), rest = uid & 31;
                      RUN_B(attn_body::attn_unit<8>((long)NPROW + (long)seq * 2048, 2048, rest >> 3, rest & 7, (attn_body::bf16*)proj, ssq, (char*)lds)); } }
                if (args.amask & 2) for (int it = vcu; it < 1152; it += G) { long base; int S_, h, gr0;
                    if (it < 384) { const int sq = it / 192, r = it % 192; base = (long)sq * 8192; S_ = 8192; h = r / 32; gr0 = 4 * (r % 32); }
                    else { const int i2 = it - 384, sq = i2 / 48, r = i2 % 48; base = (long)NPROW + (long)sq * 2048; S_ = 2048; h = r / 8; gr0 = 4 * (r % 8); }
                    RUN_C(wa::c_unit(base, S_, h, gr0, proj, rel_bias + (size_t)l * 6 * 465, ssq, (wa::lds_ptr)L)); }
                if (args.amask & 4) for (int it = vcu; it < 2304; it += G) { long base; int S_, h, pat, u;
                    if (it < 768) { const int sq = it / 384, r = it % 384; base = (long)sq * 8192; S_ = 8192; h = r / 64; pat = (r % 64) / 32; u = r % 32; }
                    else { const int i2 = it - 768, sq = i2 / 96, r = i2 % 96; base = (long)NPROW + (long)sq * 2048; S_ = 2048; h = r / 16; pat = (r % 16) / 8; u = r % 8; }
                    RUN_A(wa::a_unit(base, S_, h, pat, u, proj, U, LSE, ssq, (wa::lds_ptr)L)); }
            } else if (sub == 2) {
                if (args.amask & 4) for (int it = vcu; it < 1152; it += G) { long base; int S_, h, u;
                    if (it < 384) { const int sq = it / 192, r = it % 192; base = (long)sq * 8192; S_ = 8192; h = r / 32; u = r % 32; }
                    else { const int i2 = it - 384, sq = i2 / 48, r = i2 % 48; base = (long)NPROW + (long)sq * 2048; S_ = 2048; h = r / 8; u = r % 8; }
                    RUN_A(wa::a_unit(base, S_, h, 2, u, proj, U, LSE, ssq, (wa::lds_ptr)L)); }
            } else if (sub == 3) {
                pg8::Gemm g{proj, WOUT + (size_t)l * 1024 * 1024, NTOK, 1024, 1024, 3840}; pg8::StaticOrder S; S.init(NTOK, 1024, G, bx);
                pg8::EpiRaw E{U, ssq2, ssq};
                RUN_G2(pg8::gemm_phase<pg8::EpiRaw, pg8::StaticOrder, pg8::AMapY, true, true>(L, g, S, E));
            } else {
                for (int m = gw; m < NTOK; m += NGW) { const float* xrow = l == 0 ? (m < NPROW ? xp + (size_t)m * 1024 : xs + (size_t)(m - NPROW) * 1024) : args.out + (size_t)m * 1024;
                    finish_row(xrow, args.out + (size_t)m * 1024, U + (size_t)m * 1024, ssq2 + (size_t)m * 16, norm_post + l * 1024, rpre + m, lane); }
            }
        }
        if (ph + 1 < hi) xcd_barrier(bar);
    }
}

#ifndef MIX
#define MIX 0
#endif
static void launch_mk(Args a, int lo, int hi, hipStream_t stream) { a.ph_lo = lo; a.ph_hi = hi; hipLaunchKernelGGL(mk_fwd, dim3(256), dim3(NWAVES * 64), LDS_BYTES, stream, a); }
extern "C" void kernel_launch(void* const* d_in, const int* in_sizes, int n_in, void* d_out, int out_size, void* d_ws, size_t ws_size, hipStream_t stream) {
    static int ready = 0;
    if (ready == 0) {
        ready = -1;
        if (n_in != 10 || out_size != NTOK * DMODEL || ws_size < WS_END) { fprintf(stderr, "kernel_launch: unexpected shapes / workspace (%zu < %zu)\n", ws_size, (size_t)WS_END); return; }
        int dev = 0, cus = 0;
        if (hipGetDevice(&dev) != hipSuccess || hipDeviceGetAttribute(&cus, hipDeviceAttributeMultiprocessorCount, dev) != hipSuccess) return;
        if (cus != 256) { fprintf(stderr, "kernel_launch: built for 256 CUs, found %d\n", cus); return; }
        if (hipFuncSetAttribute((const void*)mk_fwd, hipFuncAttributeMaxDynamicSharedMemorySize, LDS_BYTES) != hipSuccess) return;
        int per_cu = 0; (void)hipOccupancyMaxActiveBlocksPerMultiprocessor(&per_cu, (const void*)mk_fwd, NWAVES * 64, LDS_BYTES); (void)hipGetLastError();
        if (per_cu < 1) fprintf(stderr, "kernel_launch: occupancy query reports %d blocks per CU\n", per_cu);
        ready = 1;
    }
    if (ready < 0) return;
    Args a{};
    for (int i = 0; i < 10; ++i) a.in[i] = (const float*)d_in[i];
    a.out = (float*)d_out; a.ws = (unsigned char*)d_ws; a.amask = 7;
    unsigned char* ws = (unsigned char*)d_ws;
#if MIX == 0
    (void)hipMemsetAsync(ws + WS_CTL, 0, CTL_ZERO_BYTES, stream);
    launch_mk(a, 0, N_PHASES, stream);
#else
    using nv::bf16_t; using nv::k_inproj; using nv::k_attnA; using nv::k_attnB; using nv::k_attnC; using nv::k_outproj; using nv::k_finish;
    bf16_t* proj = (bf16_t*)(ws + WS_PROJ); bf16_t* U = (bf16_t*)(ws + WS_U); float* ssq = (float*)(ws + WS_SSQ); float* ssq2 = (float*)(ws + WS_SSQ2); float* rpre = (float*)(ws + WS_RPRE);
    float* tabA = (float*)(ws + WS_TABA); float* tabR = (float*)(ws + WS_TABR); float* tabC = (float*)(ws + WS_TABC);
    const float* xp = a.in[0]; const float* xs = a.in[1];
    const float qs = (MIX & 1) ? 0.125f : 0.6931471805599453f;
    launch_mk(a, 0, 1, stream);
    for (int l = 0; l < 2; ++l) {
        if (MIX & 1) k_inproj<<<dim3(NTOK / 64, 60), 256, 0, stream>>>(U, rpre, a.in[3] + (size_t)l * 1024 * 3840, a.in[2] + l * 1024, a.in[4] + l * 64, a.in[5] + l * 64, tabA, tabR, tabC, proj);
        else launch_mk(a, 1 + 5 * l, 2 + 5 * l, stream);
        const int fastmask = ((MIX & 2) ? 0 : 1) | ((MIX & 4) ? 0 : 2) | ((MIX & 8) ? 0 : 4);
        if (fastmask) { Args b = a; b.amask = fastmask; launch_mk(b, 2 + 5 * l, 3 + 5 * l, stream); if (fastmask & 4) launch_mk(b, 3 + 5 * l, 4 + 5 * l, stream); }
        if (MIX & 2) k_attnB<<<dim3(192, 4), 256, 0, stream>>>(proj, ssq, qs);
        if (MIX & 8) k_attnA<<<dim3(NTOK / 256, 6), 256, 0, stream>>>(proj, ssq, qs);
        if (MIX & 4) k_attnC<<<dim3(NTOK / 256, 6), 256, 0, stream>>>(proj, a.in[6] + (size_t)l * 6 * 465, ssq, qs);
        if (MIX & 16) k_outproj<<<dim3(NTOK / 64, 16), 256, 0, stream>>>(proj, ssq, a.in[8] + (size_t)l * 1024 * 1024, a.in[7] + l * 1024, U, ssq2);
        else launch_mk(a, 4 + 5 * l, 5 + 5 * l, stream);
        if (MIX & 32) k_finish<<<NTOK, 256, 0, stream>>>(xp, xs, l, a.out, U, ssq2, a.in[9] + l * 1024, rpre);
        else launch_mk(a, 5 + 5 * l, 6 + 5 * l, stream);
    }
#endif
}
```

```cpp
#define MIX 0
#include <hip/hip_runtime.h>
#include <hip/hip_bf16.h>
#include <cstdio>
#include <cstdint>
#include <cmath>
__device__ __forceinline__ int tidx() { int t = threadIdx.x; asm volatile("" : "+v"(t)); return t; }
template <class T> __device__ __forceinline__ T* opaque_s(T* p) { asm volatile("" : "+s"(p)); return p; }
#if defined(MIX) && MIX != 0
namespace nv {
constexpr int DM = 1024, NTOK = 49152, NPROW = 16384, SEQP = 8192, SEQS = 2048, INW = 3840;
constexpr float EPS = 1e-6f;
typedef unsigned short bf16_t;
__device__ __forceinline__ bf16_t f2bf(float f) { unsigned u = __float_as_uint(f); u += 0x7fffu + ((u >> 16) & 1u); return (bf16_t)(u >> 16); }
__device__ __forceinline__ float bf2f(bf16_t b) { return __uint_as_float(((unsigned)b) << 16); }
__device__ __forceinline__ void row_info(int row, int& base, int& S, int& t) {
    if (row < NPROW) { S = SEQP; base = row & ~(SEQP - 1); t = row & (SEQP - 1); }
    else { S = SEQS; const int r = row - NPROW; base = NPROW + (r & ~(SEQS - 1)); t = r & (SEQS - 1); }
}
constexpr size_t WS_PROJ = 0;
constexpr size_t WS_U = WS_PROJ + (size_t)NTOK * INW * 2;
constexpr size_t WS_SSQ = WS_U + (size_t)NTOK * DM * 2;
constexpr size_t WS_SSQ2 = WS_SSQ + (size_t)NTOK * 16 * 4;
constexpr size_t WS_RPRE = WS_SSQ2 + (size_t)NTOK * 16 * 4;
constexpr size_t WS_TABA = WS_RPRE + (size_t)NTOK * 4;
constexpr size_t WS_TABR = WS_TABA + (size_t)8192 * 16 * 4;
constexpr size_t WS_TABC = WS_TABR + (size_t)128 * 32 * 4;
constexpr size_t WS_END = WS_TABC + (size_t)64 * 32 * 4;

__global__ void k_tables(float* tabA, float* tabR, float* tabC) {
    const int i = blockIdx.x * blockDim.x + threadIdx.x;
    if (i < 8192 * 8) { const int t = i >> 3, j = i & 7; const double f = pow(500000.0, -(double)j / 8.0); const double a = (double)t * f; tabA[t * 16 + j] = (float)cos(a); tabA[t * 16 + 8 + j] = (float)sin(a); }
    if (i < 128 * 16) { const int t = i >> 4, j = i & 15; const double f = pow(10000.0, -(double)j / 16.0); const double a = (double)t * f; tabR[t * 32 + j] = (float)cos(a); tabR[t * 32 + 16 + j] = (float)sin(a); }
    if (i < 64 * 16) { const int t = i >> 4, j = i & 15; const double f = pow(10000.0, -(double)j / 16.0); const double a = (double)t * f; tabC[t * 32 + j] = (float)cos(a); tabC[t * 32 + 16 + j] = (float)sin(a); }
}
__global__ void k_prep(const float* xp, const float* xs, bf16_t* xb, float* rpre) {
    const int row = blockIdx.x, tid = threadIdx.x;
    const float* x = row < NPROW ? xp + (size_t)row * DM : xs + (size_t)(row - NPROW) * DM;
    const float4 v = ((const float4*)x)[tid];
    float s = v.x * v.x + v.y * v.y + v.z * v.z + v.w * v.w;
    __shared__ float red[4];
    for (int o = 32; o; o >>= 1) s += __shfl_xor(s, o);
    if ((tid & 63) == 0) red[tid >> 6] = s;
    __syncthreads();
    s = red[0] + red[1] + red[2] + red[3];
    if (tid == 0) rpre[row] = rsqrtf(s / DM + EPS);
    ushort4 o; o.x = f2bf(v.x); o.y = f2bf(v.y); o.z = f2bf(v.z); o.w = f2bf(v.w);
    ((ushort4*)(xb + (size_t)row * DM))[tid] = o;
}
__global__ void __launch_bounds__(256) k_inproj(const bf16_t* xb, const float* rpre, const float* W  , const float* gpre, const float* qn, const float* kn,
                                                const float* tabA, const float* tabR, const float* tabC, bf16_t* proj) {
    __shared__ float As[16][68], Bs[16][68], Ct[64][65];
    const int tid = threadIdx.x, tx = tid & 15, ty = tid >> 4, row0 = blockIdx.x * 64, hidx = blockIdx.y, n0 = hidx * 64;
    float acc[4][4] = {};
    for (int k0 = 0; k0 < DM; k0 += 16) {
        { const int r = tid >> 2, kk = (tid & 3) * 4; const ushort4 a = *(const ushort4*)(xb + (size_t)(row0 + r) * DM + k0 + kk);
          As[kk][r] = bf2f(a.x); As[kk + 1][r] = bf2f(a.y); As[kk + 2][r] = bf2f(a.z); As[kk + 3][r] = bf2f(a.w); }
        { const int kr = tid >> 4, c = (tid & 15) * 4; const float4 b = *(const float4*)(W + (size_t)(k0 + kr) * INW + n0 + c); const float g = gpre[k0 + kr];
          Bs[kr][c] = b.x * g; Bs[kr][c + 1] = b.y * g; Bs[kr][c + 2] = b.z * g; Bs[kr][c + 3] = b.w * g; }
        __syncthreads();
#pragma unroll
        for (int kk = 0; kk < 16; ++kk) {
            float a[4], b[4];
#pragma unroll
            for (int i = 0; i < 4; ++i) { a[i] = As[kk][ty * 4 + i]; b[i] = Bs[kk][tx * 4 + i]; }
#pragma unroll
            for (int i = 0; i < 4; ++i)
#pragma unroll
                for (int j = 0; j < 4; ++j) acc[i][j] += a[i] * b[j];
        }
        __syncthreads();
    }
#pragma unroll
    for (int i = 0; i < 4; ++i) { const float r = rpre[row0 + ty * 4 + i];
#pragma unroll
        for (int j = 0; j < 4; ++j) Ct[ty * 4 + i][tx * 4 + j] = acc[i][j] * r; }
    __syncthreads();
    if (tid < 64) {
        const int row = row0 + tid; int base, S, t; row_info(row, base, S, t);
        float v[64];
#pragma unroll
        for (int d = 0; d < 64; ++d) v[d] = Ct[tid][d];
        if (hidx < 12) {
            const float* tb = tabA + t * 16;
#pragma unroll
            for (int j = 0; j < 8; ++j) { const float c = tb[j], s = tb[8 + j], x1 = v[j], x2 = v[8 + j]; v[j] = x1 * c - x2 * s; v[8 + j] = x2 * c + x1 * s; }
        } else if (hidx >= 24 && hidx < 30) {
            const float* g = hidx < 28 ? qn : kn;
            float s = 0.f;
#pragma unroll
            for (int d = 0; d < 64; ++d) s += v[d] * v[d];
            const float r = rsqrtf(s / 64.f + EPS);
#pragma unroll
            for (int d = 0; d < 64; ++d) v[d] = v[d] * r * g[d];
            const float* tr = tabR + (t >> 6) * 32; const float* tc = tabC + (t & 63) * 32;
#pragma unroll
            for (int j = 0; j < 16; ++j) { float c = tr[j], sn = tr[16 + j], x1 = v[j], x2 = v[16 + j]; v[j] = x1 * c - x2 * sn; v[16 + j] = x2 * c + x1 * sn;
                c = tc[j]; sn = tc[16 + j]; x1 = v[32 + j]; x2 = v[48 + j]; v[32 + j] = x1 * c - x2 * sn; v[48 + j] = x2 * c + x1 * sn; }
        }
        bf16_t* o = proj + (size_t)row * INW + n0;
#pragma unroll
        for (int d = 0; d < 64; d += 4) { ushort4 w; w.x = f2bf(v[d]); w.y = f2bf(v[d + 1]); w.z = f2bf(v[d + 2]); w.w = f2bf(v[d + 3]); *(ushort4*)(o + d) = w; }
    }
}
__device__ __forceinline__ float silu(float z) { return z / (1.f + __expf(-z)); }
__global__ void __launch_bounds__(256) k_attnB(bf16_t* proj, float* ssq, float qs) {
    __shared__ float Ks[64][64], Vs[64][64];
    const int tid = threadIdx.x, h = blockIdx.y, kvh = h >> 1;
    int qb = blockIdx.x, base, S;
    if (qb < 64) { base = (qb >> 5) * SEQP; S = SEQP; qb &= 31; } else { qb -= 64; base = NPROW + (qb >> 3) * SEQS; S = SEQS; qb &= 7; }
    const int row = base + qb * 256 + tid;
    bf16_t* qp = proj + (size_t)row * INW + 1536 + h * 64;
    float q[64], o[64];
#pragma unroll
    for (int d = 0; d < 64; ++d) { q[d] = bf2f(qp[d]) * qs; o[d] = 0.f; }
    float m = -1e30f, l = 0.f;
    for (int kt = 0; kt < S; kt += 64) {
        { const int r = tid >> 2, d0 = (tid & 3) * 16; const bf16_t* kp = proj + (size_t)(base + kt + r) * INW + 1792 + kvh * 64 + d0; const bf16_t* vp = proj + (size_t)(base + kt + r) * INW + 1920 + kvh * 64 + d0;
#pragma unroll
          for (int i = 0; i < 16; ++i) { Ks[r][d0 + i] = bf2f(kp[i]); Vs[r][d0 + i] = bf2f(vp[i]); } }
        __syncthreads();
        for (int j0 = 0; j0 < 64; j0 += 8) {
            float s[8]; float cm = -1e30f;
#pragma unroll
            for (int j = 0; j < 8; ++j) { float a = 0.f;
#pragma unroll
                for (int d = 0; d < 64; ++d) a += q[d] * Ks[j0 + j][d];
                s[j] = a; cm = fmaxf(cm, a); }
            const float mn = fmaxf(m, cm), corr = __expf(m - mn); m = mn; l *= corr;
#pragma unroll
            for (int d = 0; d < 64; ++d) o[d] *= corr;
#pragma unroll
            for (int j = 0; j < 8; ++j) { const float p = __expf(s[j] - mn); l += p;
#pragma unroll
                for (int d = 0; d < 64; ++d) o[d] += p * Vs[j0 + j][d]; }
        }
        __syncthreads();
    }
    const float il = 1.f / l; const bf16_t* zp = proj + (size_t)row * INW + 2048 + h * 64; float sq = 0.f;
#pragma unroll
    for (int d = 0; d < 64; ++d) { const float y = o[d] * il * silu(bf2f(zp[d])); const bf16_t yb = f2bf(y); const float yr = bf2f(yb); sq += yr * yr; qp[d] = yb; }
    ssq[(size_t)row * 16 + 6 + h] = sq;
}
__global__ void __launch_bounds__(256) k_attnA(bf16_t* proj, float* ssq, float qs) {
    const int row = blockIdx.x * 256 + threadIdx.x, h = blockIdx.y; int base, S, t; row_info(row, base, S, t);
    bf16_t* qp = proj + (size_t)row * INW + h * 64;
    float q[64], o[64];
#pragma unroll
    for (int d = 0; d < 64; ++d) { q[d] = bf2f(qp[d]) * qs; o[d] = 0.f; }
    float m = -1e30f, l = 0.f;
    for (int p = 0; p < 3; ++p) { const int dil = p == 0 ? 1 : (p == 1 ? 4 : 16);
        for (int dlt = -64; dlt <= 64; ++dlt) { const int tk = t + dlt * dil; if (tk < 0 || tk >= S) continue;
            const bf16_t* kp = proj + (size_t)(base + tk) * INW + 384 + h * 64; const bf16_t* vp = kp + 384;
            float s = 0.f;
#pragma unroll
            for (int d = 0; d < 64; ++d) s += q[d] * bf2f(kp[d]);
            const float mn = fmaxf(m, s), corr = __expf(m - mn), pr = __expf(s - mn); m = mn; l = l * corr + pr;
#pragma unroll
            for (int d = 0; d < 64; ++d) o[d] = o[d] * corr + pr * bf2f(vp[d]); } }
    const float il = 1.f / l; const bf16_t* zp = proj + (size_t)row * INW + 1152 + h * 64; float sq = 0.f;
    bf16_t* yp = qp;
#pragma unroll
    for (int d = 0; d < 64; ++d) { const float y = o[d] * il * silu(bf2f(zp[d])); const bf16_t yb = f2bf(y); const float yr = bf2f(yb); sq += yr * yr; yp[d] = yb; }
    ssq[(size_t)row * 16 + h] = sq;
}
__global__ void __launch_bounds__(256) k_attnC(bf16_t* proj, const float* relb  , float* ssq, float qs) {
    const int row = blockIdx.x * 256 + threadIdx.x, h = blockIdx.y; int base, S, t; row_info(row, base, S, t);
    const int R = S >> 6, gr = t >> 6, gc = t & 63;
    int rs = gr - 4; rs = rs < 0 ? 0 : (rs > R - 8 ? R - 8 : rs);
    int cs = gc - 8; cs = cs < 0 ? 0 : (cs > 48 ? 48 : cs);
    bf16_t* qp = proj + (size_t)row * INW + 2304 + h * 64;
    float q[64], o[64];
#pragma unroll
    for (int d = 0; d < 64; ++d) { q[d] = bf2f(qp[d]) * qs; o[d] = 0.f; }
    float m = -1e30f, l = 0.f;
    for (int i = 0; i < 8; ++i) { const int kr = rs + i, ro = kr - gr + 7;
        for (int j = 0; j < 16; ++j) { const int kc = cs + j; int co = kc - gc + 15; co = co < 0 ? 0 : (co > 30 ? 30 : co);
            const int tk = kr * 64 + kc;
            const bf16_t* kp = proj + (size_t)(base + tk) * INW + 2688 + h * 64; const bf16_t* vp = kp + 384;
            float s = relb[(h * 15 + ro) * 31 + co];
#pragma unroll
            for (int d = 0; d < 64; ++d) s += q[d] * bf2f(kp[d]);
            const float mn = fmaxf(m, s), corr = __expf(m - mn), pr = __expf(s - mn); m = mn; l = l * corr + pr;
#pragma unroll
            for (int d = 0; d < 64; ++d) o[d] = o[d] * corr + pr * bf2f(vp[d]); } }
    const float il = 1.f / l; const bf16_t* zp = proj + (size_t)row * INW + 3456 + h * 64; float sq = 0.f;
#pragma unroll
    for (int d = 0; d < 64; ++d) { const float y = o[d] * il * silu(bf2f(zp[d])); const bf16_t yb = f2bf(y); const float yr = bf2f(yb); sq += yr * yr; qp[d] = yb; }
    ssq[(size_t)row * 16 + 10 + h] = sq;
}
__device__ __forceinline__ int colmap(int k) { return k < 384 ? k : (k < 640 ? 1536 + (k - 384) : 2304 + (k - 640)); }
__global__ void __launch_bounds__(256) k_outproj(const bf16_t* proj, const float* ssq, const float* W  , const float* gain, bf16_t* raw, float* ssq2) {
    __shared__ float As[16][68], Bs[16][68], rb[64][3], red[64][17];
    const int tid = threadIdx.x, tx = tid & 15, ty = tid >> 4, row0 = blockIdx.x * 64, n0 = blockIdx.y * 64;
    if (tid < 64) { const float* s = ssq + (size_t)(row0 + tid) * 16; float a = 0.f, b = 0.f, c = 0.f;
        for (int i = 0; i < 6; ++i) a += s[i]; for (int i = 6; i < 10; ++i) b += s[i]; for (int i = 10; i < 16; ++i) c += s[i];
        rb[tid][0] = rsqrtf(a / 384.f + EPS); rb[tid][1] = rsqrtf(b / 256.f + EPS); rb[tid][2] = rsqrtf(c / 384.f + EPS); }
    __syncthreads();
    float acc[4][4] = {};
    for (int k0 = 0; k0 < DM; k0 += 16) {
        const int br = k0 < 384 ? 0 : (k0 < 640 ? 1 : 2);
        { const int r = tid >> 2, kk = (tid & 3) * 4; const ushort4 a = *(const ushort4*)(proj + (size_t)(row0 + r) * INW + colmap(k0 + kk)); const float sc = rb[r][br];
          As[kk][r] = bf2f(a.x) * sc * gain[k0 + kk]; As[kk + 1][r] = bf2f(a.y) * sc * gain[k0 + kk + 1]; As[kk + 2][r] = bf2f(a.z) * sc * gain[k0 + kk + 2]; As[kk + 3][r] = bf2f(a.w) * sc * gain[k0 + kk + 3]; }
        { const int kr = tid >> 4, c = (tid & 15) * 4; const float4 b = *(const float4*)(W + (size_t)(k0 + kr) * DM + n0 + c);
          Bs[kr][c] = b.x; Bs[kr][c + 1] = b.y; Bs[kr][c + 2] = b.z; Bs[kr][c + 3] = b.w; }
        __syncthreads();
#pragma unroll
        for (int kk = 0; kk < 16; ++kk) {
            float a[4], b[4];
#pragma unroll
            for (int i = 0; i < 4; ++i) { a[i] = As[kk][ty * 4 + i]; b[i] = Bs[kk][tx * 4 + i]; }
#pragma unroll
            for (int i = 0; i < 4; ++i)
#pragma unroll
                for (int j = 0; j < 4; ++j) acc[i][j] += a[i] * b[j];
        }
        __syncthreads();
    }
#pragma unroll
    for (int i = 0; i < 4; ++i) { float s = 0.f; ushort4 w; w.x = f2bf(acc[i][0]); w.y = f2bf(acc[i][1]); w.z = f2bf(acc[i][2]); w.w = f2bf(acc[i][3]);
#pragma unroll
        for (int j = 0; j < 4; ++j) s += acc[i][j] * acc[i][j];
        red[ty * 4 + i][tx] = s;
        *(ushort4*)(raw + (size_t)(row0 + ty * 4 + i) * DM + n0 + tx * 4) = w; }
    __syncthreads();
    if (tid < 64) { float s = 0.f; for (int i = 0; i < 16; ++i) s += red[tid][i]; ssq2[(size_t)(row0 + tid) * 16 + blockIdx.y] = s; }
}
__global__ void k_finish(const float* xp, const float* xs, int from_out, float* out, bf16_t* U, const float* ssq2, const float* gpost, float* rpre) {
    const int row = blockIdx.x, tid = threadIdx.x;
    const float* x = from_out ? out + (size_t)row * DM : (row < NPROW ? xp + (size_t)row * DM : xs + (size_t)(row - NPROW) * DM);
    float s2 = 0.f; for (int i = 0; i < 16; ++i) s2 += ssq2[(size_t)row * 16 + i];
    const float r = rsqrtf(s2 / DM + EPS);
    const float4 v = ((const float4*)x)[tid]; const float4 g = ((const float4*)gpost)[tid];
    const ushort4 rw = ((const ushort4*)(U + (size_t)row * DM))[tid];
    float4 n; n.x = v.x + bf2f(rw.x) * r * g.x; n.y = v.y + bf2f(rw.y) * r * g.y; n.z = v.z + bf2f(rw.z) * r * g.z; n.w = v.w + bf2f(rw.w) * r * g.w;
    ((float4*)(out + (size_t)row * DM))[tid] = n;
    float s = n.x * n.x + n.y * n.y + n.z * n.z + n.w * n.w;
    __shared__ float red[4];
    for (int o = 32; o; o >>= 1) s += __shfl_xor(s, o);
    if ((tid & 63) == 0) red[tid >> 6] = s;
    __syncthreads();
    s = red[0] + red[1] + red[2] + red[3];
    if (tid == 0) rpre[row] = rsqrtf(s / DM + EPS);
    ushort4 o; o.x = f2bf(n.x); o.y = f2bf(n.y); o.z = f2bf(n.z); o.w = f2bf(n.w);
    ((ushort4*)(U + (size_t)row * DM))[tid] = o;
}
}
#endif
namespace pg8 {
#define PG8_LAS __attribute__((address_space(3)))
typedef unsigned short bf16_t;
typedef short bf16x8 __attribute__((ext_vector_type(8)));
typedef float f32x4 __attribute__((ext_vector_type(4)));
typedef unsigned u32x4 __attribute__((ext_vector_type(4)));
constexpr int BM = 256, BK = 64, HALF = 128, HTB = HALF * BK * 2  , STAGE_BYTES = 8 * HTB, NXCD = 8, WGM = 8;

__host__ __device__ __forceinline__ int lds_byte(int r, int c) { const int st = (r >> 4) * 2 + (c >> 5), rr = r & 15, cc = c & 31, ob = rr * 64 + cc * 2; return st * 1024 + (ob ^ (((ob >> 9) & 1) << 5)); }
__host__ __device__ __forceinline__ void stage_rc(int b, int& R, int& C) { const int st = b / 1024, sb = b % 1024, swz = sb ^ (((sb >> 9) & 1) << 5); R = (st >> 1) * 16 + swz / 64; C = (st & 1) * 32 + (swz % 64) / 2; }
__host__ __device__ __forceinline__ int perm32(int rho) { const int n = rho >> 4, i = rho & 15; return 8 * (i >> 2) + 4 * n + (i & 3); }

struct Unit { int pm, pn; };
struct Gemm { const bf16_t* A; const bf16_t* Bt; int M, N, K, lda; };

struct StaticOrder {
    int nM, nN, nwg, G, c;
    __host__ __device__ void init(int M, int N, int G_, int c_) { nM = M / BM; nN = N / BM; nwg = nM * nN; G = G_; c = c_; }
    __host__ __device__ bool next(int i, Unit& u) const {
        const long L = (long)i * G + c; if (L >= nwg) return false;
        int wgid = (int)L; { const int q = nwg / NXCD, r = nwg % NXCD, xcd = wgid % NXCD, off = wgid / NXCD; wgid = (xcd < r ? xcd * (q + 1) : r * (q + 1) + (xcd - r) * q) + off; }
        const int nig = WGM * nN, gid = wgid / nig, fm = gid * WGM, gsz = (nM - fm) < WGM ? (nM - fm) : WGM;
        u.pm = fm + ((wgid % nig) % gsz); u.pn = (wgid % nig) / gsz; return true;
    }
    __device__ __forceinline__ void a_ready(const Unit&) const {}
    __device__ __forceinline__ void done(const Unit&) const {}
};

__device__ __forceinline__ unsigned cvt_pk_bf16(float lo, float hi) { unsigned r; asm volatile("v_cvt_pk_bf16_f32 %0, %1, %2" : "=v"(r) : "v"(lo), "v"(hi)); return r; }
constexpr float QC2 = 0.125f * 1.4426950408889634f;
constexpr float EPSN = 1e-6f;
__device__ __forceinline__ int row_pos(int row) { return row < 16384 ? (row & 8191) : ((row - 16384) & 2047); }

struct EpiProj {
    static constexpr bool PERM = true, AFTER_DRAIN = false;
    bf16_t* proj; const float* rpre; const float* qn; const float* kn; const float* tabA; const float* tabR; const float* tabC;
    __device__ __forceinline__ void ustart(const Unit&, int, PG8_LAS unsigned char*) const {}
    __device__ __forceinline__ void khook(f32x4 (&)[2][2][4][2], const Unit&, int, int, int, int, PG8_LAS unsigned char*) const {}
    __device__ __forceinline__ void operator()(const f32x4 (&acc)[2][2][4][2], const Unit& u, int ui, int wr, int wc, int fr, int fq, PG8_LAS unsigned char* lds) const {
        const int hidx = u.pn * 4 + wc;
        const int type = hidx < 12 ? 1 : ((hidx >= 24 && hidx < 30) ? 2 : 0);
        const bool qsc = (hidx < 6) || (hidx >= 24 && hidx < 28) || (hidx >= 36 && hidx < 42);
        const float osc = qsc ? QC2 : 1.0f;
        const float* gv = hidx < 28 ? qn : kn;
        bf16_t* obase = proj + (size_t)hidx * 64 + 8 * fq;
#pragma unroll
        for (int ai = 0; ai < 2; ++ai)
#pragma unroll
            for (int m = 0; m < 4; ++m) {
                const int row = u.pm * BM + ai * HALF + wr * 64 + m * 16 + fr; const int t = row_pos(row);
                const float rp = rpre[row];
                f32x4 v[2][2];
#pragma unroll
                for (int bj = 0; bj < 2; ++bj)
#pragma unroll
                    for (int n = 0; n < 2; ++n) v[bj][n] = acc[ai][bj][m][n] * rp;
                if (type == 1) {
                    const float sg = fq == 0 ? -1.f : 1.f; const bool on = fq < 2;
#pragma unroll
                    for (int n = 0; n < 2; ++n) { const f32x4 c4 = *(const f32x4*)(tabA + t * 16 + 4 * n), s4 = *(const f32x4*)(tabA + t * 16 + 8 + 4 * n);
#pragma unroll
                        for (int e = 0; e < 4; ++e) { const float own = v[0][n][e], oth = __shfl_xor(own, 16); const float nv_ = own * c4[e] + sg * oth * s4[e]; v[0][n][e] = on ? nv_ : own; } }
                } else if (type == 2) {
                    float ss = 0.f;
#pragma unroll
                    for (int bj = 0; bj < 2; ++bj)
#pragma unroll
                        for (int n = 0; n < 2; ++n) ss += (v[bj][n][0] * v[bj][n][0] + v[bj][n][1] * v[bj][n][1]) + (v[bj][n][2] * v[bj][n][2] + v[bj][n][3] * v[bj][n][3]);
                    ss += __shfl_xor(ss, 16); ss += __shfl_xor(ss, 32);
                    const float rn = rsqrtf(ss * (1.0f / 64.0f) + EPSN);
#pragma unroll
                    for (int bj = 0; bj < 2; ++bj)
#pragma unroll
                        for (int n = 0; n < 2; ++n) { const f32x4 g4 = *(const f32x4*)(gv + 32 * bj + 8 * fq + 4 * n); v[bj][n] = v[bj][n] * rn * g4; }
                    const float sg = fq < 2 ? -1.f : 1.f;
#pragma unroll
                    for (int bj = 0; bj < 2; ++bj) { const float* tb = bj == 0 ? tabR + (t >> 6) * 32 : tabC + (t & 63) * 32;
#pragma unroll
                        for (int n = 0; n < 2; ++n) { const f32x4 c4 = *(const f32x4*)(tb + 8 * (fq & 1) + 4 * n), s4 = *(const f32x4*)(tb + 16 + 8 * (fq & 1) + 4 * n);
#pragma unroll
                            for (int e = 0; e < 4; ++e) { const float own = v[bj][n][e], oth = __shfl_xor(own, 32); v[bj][n][e] = own * c4[e] + sg * oth * s4[e]; } } }
                }
                bf16_t* rowp = obase + (size_t)row * 3840;
#pragma unroll
                for (int bj = 0; bj < 2; ++bj) { const f32x4 v0 = v[bj][0] * osc, v1 = v[bj][1] * osc; u32x4 w; w.x = cvt_pk_bf16(v0[0], v0[1]); w.y = cvt_pk_bf16(v0[2], v0[3]); w.z = cvt_pk_bf16(v1[0], v1[1]); w.w = cvt_pk_bf16(v1[2], v1[3]);
                    *(u32x4*)(rowp + 32 * bj) = w; }
                asm volatile("" ::: "memory");
            }
    }
};

constexpr int FT_OFF = 131072;
struct EpiRaw {
    static constexpr bool PERM = true, AFTER_DRAIN = false;
    bf16_t* raw; float* ssq2; const float* ssq;
    __device__ __forceinline__ void ustart(const Unit& u, int ui, PG8_LAS unsigned char* lds) const {
        const int tid = tidx();
        if (tid < 256) { const f32x4* s = (const f32x4*)(ssq + (size_t)(u.pm * BM + tid) * 16); const f32x4 a = s[0], b = s[1], c = s[2], d = s[3];
            const float sa = (a[0] + a[1]) + (a[2] + a[3]) + (b[0] + b[1]), sb = (b[2] + b[3]) + (c[0] + c[1]), sc = (c[2] + c[3]) + (d[0] + d[1]) + (d[2] + d[3]);
            const float rA = rsqrtf(sa * (1.0f / 384.0f) + EPSN), rB = rsqrtf(sb * (1.0f / 256.0f) + EPSN), rC = rsqrtf(sc * (1.0f / 384.0f) + EPSN);
            *(PG8_LAS f32x4*)(lds + FT_OFF + (ui & 1) * 4096 + tid * 16) = (f32x4){rA / rB, rB / rC, rC, 0.f}; }
    }
    __device__ __forceinline__ void khook(f32x4 (&acc)[2][2][4][2], const Unit&, int t, int ui, int wr, int fr, PG8_LAS unsigned char* lds) const {
        const int tq = t;
        if (tq == 6 || tq == 10) { int b = (wr * 64 + fr) * 16 + (ui & 1) * 4096 + (tq == 6 ? 0 : 4); asm volatile("" : "+v"(b));
            const PG8_LAS unsigned char* p = lds + FT_OFF + b;
#pragma unroll
            for (int ai = 0; ai < 2; ++ai)
#pragma unroll
                for (int m = 0; m < 4; ++m) { const float f = *(const PG8_LAS float*)(p + (ai * HALF + m * 16) * 16);
#pragma unroll
                    for (int bj = 0; bj < 2; ++bj)
#pragma unroll
                        for (int n = 0; n < 2; ++n) acc[ai][bj][m][n] *= f;
                    asm volatile("" ::: "memory"); } }
    }
    __device__ __forceinline__ void operator()(const f32x4 (&acc)[2][2][4][2], const Unit& u, int ui, int wr, int wc, int fr, int fq, PG8_LAS unsigned char* lds) const {
        int rl0 = wr * 64 + fr; asm volatile("" : "+v"(rl0));
        const PG8_LAS unsigned char* p = lds + FT_OFF + (ui & 1) * 4096 + rl0 * 16 + 8;
        const unsigned col0 = (unsigned)(u.pn * BM + wc * 32 + 8 * fq);
        const unsigned row0 = (unsigned)(u.pm * BM + rl0);
#pragma unroll
        for (int ai = 0; ai < 2; ++ai)
#pragma unroll
            for (int m = 0; m < 4; ++m) { const unsigned row = row0 + ai * HALF + m * 16;
                const float f = *(const PG8_LAS float*)(p + (ai * HALF + m * 16) * 16);
                float ss = 0.f; bf16_t* rowp = raw + (size_t)row * 1024 + col0;
#pragma unroll
                for (int bj = 0; bj < 2; ++bj) { const f32x4 v0 = acc[ai][bj][m][0] * f, v1 = acc[ai][bj][m][1] * f;
                    ss += (v0[0] * v0[0] + v0[1] * v0[1]) + (v0[2] * v0[2] + v0[3] * v0[3]) + (v1[0] * v1[0] + v1[1] * v1[1]) + (v1[2] * v1[2] + v1[3] * v1[3]);
                    u32x4 w; w.x = cvt_pk_bf16(v0[0], v0[1]); w.y = cvt_pk_bf16(v0[2], v0[3]); w.z = cvt_pk_bf16(v1[0], v1[1]); w.w = cvt_pk_bf16(v1[2], v1[3]);
                    *(u32x4*)(rowp + bj * HALF) = w; }
                ss += __shfl_xor(ss, 16); ss += __shfl_xor(ss, 32);
                if (fq == 0) ssq2[(size_t)row * 16 + u.pn * 4 + wc] = ss;
                asm volatile("" ::: "memory"); }
    }
};
struct AMapLin { static __device__ __forceinline__ size_t koff(int t) { return (size_t)t * 128; } };
struct AMapY { static __device__ __forceinline__ size_t koff(int t) { return (size_t)(128 * t + (t >= 6 ? 2304 : 0) + (t >= 10 ? 1024 : 0)); } };
template <class Epi, class Sched, class AMap, bool ALIGN_EPI = false, bool SP2 = false>
__device__ __forceinline__ void gemm_phase(PG8_LAS unsigned char* lds, const Gemm g, const Sched& S, const Epi& E) {
    const int tid = tidx(), wid = __builtin_amdgcn_readfirstlane(tid >> 6), lane = tid & 63, wr = wid >> 2, wc = wid & 3, fr = lane & 15, fq = lane >> 4;
    const int K = g.K, nt = K / BK;
    unsigned voffA[2], voffB[2];
#pragma unroll
    for (int i = 0; i < 2; ++i) { int R, C; stage_rc(tid * 16 + i * 8192, R, C); const int Rb = Epi::PERM ? ((R & ~31) + perm32(R & 31)) : R;
        voffA[i] = (unsigned)(R * g.lda + C) * 2u; voffB[i] = (unsigned)(Rb * K + C) * 2u; }
    const size_t kstep = (size_t)(BK * 2);
    const size_t hstep = (size_t)HALF * K * 2;
    const size_t tstep = 2 * hstep;
    const size_t hstepA = (size_t)HALF * g.lda * 2, tstepA = 2 * hstepA;
    const unsigned ldsw = (unsigned)wid * 1024u;
    const int aoff = lds_byte(wr * 64 + fr, fq * 8), boff = lds_byte(wc * 32 + fr, fq * 8);
#define PG8_SA(b, h) (((b) * 2 + (h)) * HTB)
#define PG8_SB(b, h) ((4 + (b) * 2 + (h)) * HTB)
#define PG8_STAGE(bufoff, gbase, voff) do { _Pragma("unroll") for (int _i = 0; _i < 2; ++_i) \
        __builtin_amdgcn_global_load_lds((const unsigned*)((const char*)(gbase) + (voff)[_i]), (PG8_LAS unsigned*)(lds + (bufoff) + ldsw + _i * 8192), 16, 0, 0); } while (0)
#define PG8_LDA(dst, b, h) do { _Pragma("unroll") for (int m = 0; m < 4; ++m) _Pragma("unroll") for (int k = 0; k < 2; ++k) dst[m][k] = *(const PG8_LAS bf16x8*)(lds + PG8_SA(b, h) + aoff + m * 2048 + k * 1024); } while (0)
#define PG8_LDB(dst, b, h) do { _Pragma("unroll") for (int n = 0; n < 2; ++n) _Pragma("unroll") for (int k = 0; k < 2; ++k) dst[n][k] = *(const PG8_LAS bf16x8*)(lds + PG8_SB(b, h) + boff + n * 2048 + k * 1024); } while (0)
#define PG8_MMA(ai, bj, At, Bt) do { __builtin_amdgcn_s_setprio(1); _Pragma("unroll") for (int m = 0; m < 4; ++m) _Pragma("unroll") for (int n = 0; n < 2; ++n) _Pragma("unroll") for (int k = 0; k < 2; ++k) \
        acc[ai][bj][m][n] = __builtin_amdgcn_mfma_f32_16x16x32_bf16(Bt[n][k], At[m][k], acc[ai][bj][m][n], 0, 0, 0); __builtin_amdgcn_s_setprio(0); } while (0)
#define PG8_WAIT_V(n) asm volatile("s_waitcnt vmcnt(" #n ")" ::: "memory")
#define PG8_WAIT_L(n) asm volatile("s_waitcnt lgkmcnt(" #n ")" ::: "memory")
#define PG8_BAR __builtin_amdgcn_s_barrier()
#define PG8_SCHED __builtin_amdgcn_sched_barrier(0)
    Unit cur, nxt; int ui = 0;
    if (!S.next(0, cur)) return;
    f32x4 acc[2][2][4][2];
#pragma unroll
    for (int a = 0; a < 2; ++a)
#pragma unroll
        for (int b = 0; b < 2; ++b)
#pragma unroll
            for (int m = 0; m < 4; ++m)
#pragma unroll
                for (int n = 0; n < 2; ++n) acc[a][b][m][n] = (f32x4){0.f, 0.f, 0.f, 0.f};
    bf16x8 At[4][2], B0[2][2], B1[2][2];
    const char* cA = (const char*)g.A + (size_t)cur.pm * tstepA; const char* cB = (const char*)g.Bt + (size_t)cur.pn * tstep;
    S.a_ready(cur); E.ustart(cur, 0, lds);
    if constexpr (SP2) {
        PG8_STAGE(PG8_SB(0, 0), cB, voffB); PG8_STAGE(PG8_SB(0, 1), cB + hstep, voffB); PG8_STAGE(PG8_SA(0, 0), cA, voffA); PG8_STAGE(PG8_SA(0, 1), cA + hstepA, voffA);
        if (wr == 1) PG8_BAR;
        PG8_WAIT_V(2); PG8_BAR;
        PG8_STAGE(PG8_SB(1, 0), cB + kstep, voffB); PG8_STAGE(PG8_SA(1, 0), cA + AMap::koff(1), voffA); PG8_STAGE(PG8_SB(1, 1), cB + hstep + kstep, voffB);
        PG8_WAIT_V(6); PG8_BAR;
    } else {
        PG8_STAGE(PG8_SB(0, 0), cB, voffB); PG8_STAGE(PG8_SA(0, 0), cA, voffA); PG8_STAGE(PG8_SB(0, 1), cB + hstep, voffB); PG8_STAGE(PG8_SA(0, 1), cA + hstepA, voffA);
        if (wr == 1) PG8_BAR;
        PG8_WAIT_V(4); PG8_BAR;
        PG8_STAGE(PG8_SB(1, 0), cB + kstep, voffB); PG8_STAGE(PG8_SA(1, 0), cA + AMap::koff(1), voffA); PG8_STAGE(PG8_SB(1, 1), cB + hstep + kstep, voffB);
        PG8_WAIT_V(6); PG8_BAR;
    }
    for (;;) {
        const bool has_next = S.next(ui + 1, nxt);
        const char* nA = has_next ? (const char*)g.A + (size_t)nxt.pm * tstepA : cA; const char* nB = has_next ? (const char*)g.Bt + (size_t)nxt.pn * tstep : cB;
        for (int t = 0; t < nt; t += 2) {
            const bool last = (t == nt - 2);
            int tq = t; asm volatile("" : "+s"(tq));
            const char* a1 = cA + AMap::koff(tq + 1);
            const char* a2 = last ? nA : cA + AMap::koff(tq + 2); const char* b2 = last ? nB : cB + (size_t)(t + 2) * kstep;
            const char* a3 = last ? nA + AMap::koff(1) : cA + AMap::koff(tq + 3); const char* b3 = b2 + kstep;
            E.khook(acc, cur, tq, ui, wr, fr, lds);
            if (last && has_next) S.a_ready(nxt);
            if constexpr (SP2) {
            PG8_LDB(B0, 0, 0); PG8_LDB(B1, 0, 1); PG8_SCHED; PG8_LDA(At, 0, 0); PG8_STAGE(PG8_SA(1, 1), a1 + hstepA, voffA);
            PG8_WAIT_V(8); PG8_WAIT_L(0); PG8_BAR; PG8_MMA(0, 0, At, B0); PG8_MMA(0, 1, At, B1); PG8_BAR; PG8_SCHED;
            PG8_LDA(At, 0, 1); PG8_STAGE(PG8_SB(0, 0), b2, voffB); PG8_STAGE(PG8_SB(0, 1), b2 + hstep, voffB); PG8_STAGE(PG8_SA(0, 0), a2, voffA);
            PG8_WAIT_V(8); PG8_WAIT_L(0); PG8_BAR; PG8_MMA(1, 0, At, B0); PG8_MMA(1, 1, At, B1); PG8_BAR; PG8_SCHED;
            PG8_LDB(B0, 1, 0); PG8_LDB(B1, 1, 1); PG8_SCHED; PG8_LDA(At, 1, 0); PG8_STAGE(PG8_SA(0, 1), a2 + hstepA, voffA);
            PG8_WAIT_V(8); PG8_WAIT_L(0); PG8_BAR; PG8_MMA(0, 0, At, B0); PG8_MMA(0, 1, At, B1); PG8_BAR; PG8_SCHED;
            PG8_LDA(At, 1, 1); PG8_STAGE(PG8_SB(1, 0), b3, voffB); PG8_STAGE(PG8_SB(1, 1), b3 + hstep, voffB); PG8_STAGE(PG8_SA(1, 0), a3, voffA);
            PG8_WAIT_V(8); PG8_WAIT_L(0); PG8_BAR; PG8_MMA(1, 0, At, B0); PG8_MMA(1, 1, At, B1); PG8_BAR; PG8_SCHED;
            } else {
            PG8_LDB(B0, 0, 0); PG8_SCHED; PG8_LDA(At, 0, 0); PG8_STAGE(PG8_SA(1, 1), a1 + hstepA, voffA);
            PG8_WAIT_L(8); PG8_BAR; PG8_WAIT_L(0); PG8_MMA(0, 0, At, B0); PG8_BAR; PG8_SCHED;
            PG8_LDB(B1, 0, 1); PG8_STAGE(PG8_SB(0, 0), b2, voffB);
            PG8_BAR; PG8_WAIT_L(0); PG8_MMA(0, 1, At, B1); PG8_BAR;
            PG8_LDA(At, 0, 1); PG8_STAGE(PG8_SA(0, 0), a2, voffA);
            PG8_BAR; PG8_WAIT_L(0); PG8_MMA(1, 0, At, B0); PG8_BAR; PG8_SCHED;
            PG8_STAGE(PG8_SB(0, 1), b2 + hstep, voffB);
            PG8_WAIT_V(6); PG8_BAR; PG8_MMA(1, 1, At, B1); PG8_BAR;
            PG8_LDB(B0, 1, 0); PG8_SCHED; PG8_LDA(At, 1, 0); PG8_STAGE(PG8_SA(0, 1), a2 + hstepA, voffA);
            PG8_WAIT_L(8); PG8_BAR; PG8_WAIT_L(0); PG8_MMA(0, 0, At, B0); PG8_BAR; PG8_SCHED;
            PG8_LDB(B1, 1, 1); PG8_STAGE(PG8_SB(1, 0), b3, voffB);
            PG8_BAR; PG8_WAIT_L(0); PG8_MMA(0, 1, At, B1); PG8_BAR;
            PG8_LDA(At, 1, 1); PG8_STAGE(PG8_SA(1, 0), a3, voffA);
            PG8_BAR; PG8_WAIT_L(0); PG8_MMA(1, 0, At, B0); PG8_BAR; PG8_SCHED;
            PG8_STAGE(PG8_SB(1, 1), b3 + hstep, voffB);
            PG8_WAIT_V(6); PG8_BAR; PG8_MMA(1, 1, At, B1); PG8_BAR;
            }
        }
        if constexpr (ALIGN_EPI) { if (wr == 0) PG8_BAR; }
        if constexpr (!Epi::AFTER_DRAIN) { E(acc, cur, ui, wr, wc, fr, fq, lds); S.done(cur); }
        if (!has_next) break;
        E.ustart(nxt, ui + 1, lds);
#pragma unroll
        for (int a = 0; a < 2; ++a)
#pragma unroll
            for (int b = 0; b < 2; ++b)
#pragma unroll
                for (int m = 0; m < 4; ++m)
#pragma unroll
                    for (int n = 0; n < 2; ++n) acc[a][b][m][n] = (f32x4){0.f, 0.f, 0.f, 0.f};
        cur = nxt; cA = nA; cB = nB; ++ui;
        if constexpr (ALIGN_EPI) { if (wr == 1) PG8_BAR; }
    }
    PG8_WAIT_V(0);
    if constexpr (!ALIGN_EPI) { if (wr == 0) PG8_BAR; }
    PG8_BAR;
    if constexpr (Epi::AFTER_DRAIN) { E.fused(acc, cur, wr, wc, fr, fq, lds, wid, lane); S.done(cur); }
#undef PG8_SA
#undef PG8_SB
#undef PG8_STAGE
#undef PG8_LDA
#undef PG8_LDB
#undef PG8_MMA
#undef PG8_WAIT_V
#undef PG8_WAIT_L
#undef PG8_BAR
#undef PG8_SCHED
}
}

namespace attn_body {
using bf16=__hip_bfloat16;
using bf16x8=__attribute__((ext_vector_type(8)))short;
using s16x4=__attribute__((ext_vector_type(4)))short;
using f32x16=__attribute__((ext_vector_type(16)))float;
using u32x4=__attribute__((ext_vector_type(4)))unsigned;
constexpr int D=64,DM=3840;
constexpr int NW=8,QBLK=32,QB=QBLK*NW,KVBLK=64;
__device__ __forceinline__ int crow(int r,int hi){return (r&3)+8*(r>>2)+4*hi;}
#define SBAR() __builtin_amdgcn_sched_barrier(0)
#define ATTN_STORE16(p,v) (*(u32x4*)(p)=(v))
constexpr int NSLOT=3, SLOTB=8192;
constexpr int LDS_K=0, LDS_V=NSLOT*SLOTB, LDS_WS=2*NSLOT*SLOTB, LDS_OST=LDS_WS+NW*64*4, LDS_BYTES=LDS_OST+NW*4096;
constexpr float C2=0.125f*1.4426950408889634f;
__device__ __forceinline__ void glds16(const void*gsrc,unsigned lds_dst){unsigned keep;
  asm volatile("s_mov_b32 %0, m0\n\ts_mov_b32 m0, %2\n\ts_nop 0\n\tglobal_load_lds_dwordx4 %1, off\n\ts_mov_b32 m0, %0":"=&s"(keep):"v"(gsrc),"s"(lds_dst):"memory");}
__device__ __forceinline__ float max3f(float a,float b,float c){float r;asm("v_max3_f32 %0, %1, %2, %3":"=v"(r):"v"(a),"v"(b),"v"(c));return r;}
__device__ __forceinline__ float max2f(float a,float b){float r;asm("v_max_f32_e32 %0, %1, %2":"=v"(r):"v"(a),"v"(b));return r;}
__device__ __forceinline__ float fadd_s(float a,float b){float r;asm("v_add_f32_e32 %0, %1, %2":"=v"(r):"v"(a),"v"(b));return r;}
__device__ __forceinline__ float fsub_s(float a,float b){float r;asm("v_sub_f32_e32 %0, %1, %2":"=v"(r):"v"(a),"v"(b));return r;}
typedef float f32x2_t __attribute__((ext_vector_type(2))); typedef __bf16 bf16x2_t __attribute__((ext_vector_type(2)));
__device__ __forceinline__ unsigned cvtpk_s(float lo,float hi){f32x2_t v={lo,hi};bf16x2_t b=__builtin_convertvector(v,bf16x2_t);return __builtin_bit_cast(unsigned,b);}
#define WAIT_BAR(N) asm volatile("s_waitcnt vmcnt(" #N ") lgkmcnt(0)\n\ts_barrier":::"memory")

__device__ __forceinline__ void qkt(f32x16&p0,f32x16&p1,const char*Kslot,const bf16x8*qr,const f32x16&negm,int r32,int hi){
  const char*kb=Kslot+hi*1024+r32*16;
  #pragma unroll
  for(int d0=0;d0<4;++d0){
    const bf16x8 b0=*reinterpret_cast<const bf16x8*>(kb+d0*2048);
    const bf16x8 b1=*reinterpret_cast<const bf16x8*>(kb+d0*2048+512);
    if(d0==0){p0=__builtin_amdgcn_mfma_f32_32x32x16_bf16(b0,qr[0],negm,0,0,0);p1=__builtin_amdgcn_mfma_f32_32x32x16_bf16(b1,qr[0],negm,0,0,0);}
    else{p0=__builtin_amdgcn_mfma_f32_32x32x16_bf16(b0,qr[d0],p0,0,0,0);p1=__builtin_amdgcn_mfma_f32_32x32x16_bf16(b1,qr[d0],p1,0,0,0);}}
}
typedef __attribute__((address_space(3))) const char* lds_cptr;
typedef short v4i16_t __attribute__((ext_vector_type(4)));
__device__ __forceinline__ void kload8(bf16x8*kf,lds_cptr kp){
  kf[0]=*(const __attribute__((address_space(3))) bf16x8*)(kp);      kf[1]=*(const __attribute__((address_space(3))) bf16x8*)(kp+512);
  kf[2]=*(const __attribute__((address_space(3))) bf16x8*)(kp+2048); kf[3]=*(const __attribute__((address_space(3))) bf16x8*)(kp+2560);
  kf[4]=*(const __attribute__((address_space(3))) bf16x8*)(kp+4096); kf[5]=*(const __attribute__((address_space(3))) bf16x8*)(kp+4608);
  kf[6]=*(const __attribute__((address_space(3))) bf16x8*)(kp+6144); kf[7]=*(const __attribute__((address_space(3))) bf16x8*)(kp+6656);
}
__device__ __forceinline__ void kload2(bf16x8*kf,lds_cptr kp,int j){ kf[2*j]=*(const __attribute__((address_space(3))) bf16x8*)(kp+j*2048); kf[2*j+1]=*(const __attribute__((address_space(3))) bf16x8*)(kp+j*2048+512); }
__device__ __forceinline__ s16x4 vtr(lds_cptr p){ return __builtin_bit_cast(s16x4,__builtin_amdgcn_ds_read_tr16_b64_v4i16((__attribute__((address_space(3))) v4i16_t*)p)); }
__device__ __forceinline__ float rowmax(const f32x16&p0,const f32x16&p1){
  float a=max3f(p0[0],p0[1],p1[0]),b=max3f(p0[2],p0[3],p1[1]);a=max3f(a,p1[2],p1[3]);
  #pragma unroll
  for(int r=4;r<16;r+=4){a=max3f(a,p0[r],p0[r+1]);b=max3f(b,p0[r+2],p0[r+3]);a=max3f(a,p1[r],p1[r+1]);b=max3f(b,p1[r+2],p1[r+3]);}
  const float m=max2f(a,b);
  auto rr=__builtin_amdgcn_permlane32_swap(__float_as_uint(m),__float_as_uint(m),false,false);
  return max2f(__uint_as_float(rr[0]),__uint_as_float(rr[1]));
}
__device__ __forceinline__ void pv(f32x16*o,int vb,bf16x8 pa0,bf16x8 pa1,bf16x8 pa2,bf16x8 pa3){
  #pragma unroll
  for(int d0=0;d0<2;++d0){s16x4 lo[4],hi[4];
    #pragma unroll
    for(int ks=0;ks<4;++ks){
      asm volatile("ds_read_b64_tr_b16 %0,%1 offset:%c2":"=&v"(lo[ks]):"v"(vb),"i"(d0*4096+ks*1024):"memory");
      asm volatile("ds_read_b64_tr_b16 %0,%1 offset:%c2":"=&v"(hi[ks]):"v"(vb),"i"(d0*4096+ks*1024+512):"memory");}
    asm volatile("s_waitcnt lgkmcnt(0)":::"memory");SBAR();
    #define PK(k) (bf16x8){lo[k][0],lo[k][1],lo[k][2],lo[k][3],hi[k][0],hi[k][1],hi[k][2],hi[k][3]}
    o[d0]=__builtin_amdgcn_mfma_f32_32x32x16_bf16(pa0,PK(0),o[d0],0,0,0);
    o[d0]=__builtin_amdgcn_mfma_f32_32x32x16_bf16(pa1,PK(1),o[d0],0,0,0);
    o[d0]=__builtin_amdgcn_mfma_f32_32x32x16_bf16(pa2,PK(2),o[d0],0,0,0);
    o[d0]=__builtin_amdgcn_mfma_f32_32x32x16_bf16(pa3,PK(3),o[d0],0,0,0);
    #undef PK
  }
}
template<int THRL> __device__ __forceinline__ void attn_unit(long rowbase,int S,int h,int qb,bf16*P,float*ssq,char*shm){
  const int tid=tidx(),lane=tid&63,r32=lane&31,hi=lane>>5; const int wid=__builtin_amdgcn_readfirstlane(tid>>6);
  const int q0=qb*QB;
  bf16*Qw=P+(rowbase+q0+wid*QBLK)*DM+1536+h*D;
  const bf16*Kh=P+rowbase*DM+1792+(h>>1)*D,*Vh=P+rowbase*DM+1920+(h>>1)*D;
  const unsigned lds0=(unsigned)(uintptr_t)shm;
  float*wsf=(float*)(shm+LDS_WS)+wid*64;
  const bf16*ksrc=Kh+(long)lane*DM+wid*8;
  const bf16*vsrc=Vh+(long)(16*(wid&3)+(lane>>2))*DM+(wid>>2)*32+(lane&3)*8;
  const unsigned kdst=lds0+LDS_K+wid*1024, vdst=lds0+LDS_V+wid*1024;
  #define DMA_K(t,slot) glds16(ksrc+(long)(t)*KVBLK*DM,(unsigned)__builtin_amdgcn_readfirstlane(kdst+(slot)))
  #define DMA_V(t,slot) glds16(vsrc+(long)(t)*KVBLK*DM,(unsigned)__builtin_amdgcn_readfirstlane(vdst+(slot)))
  const int vb0=(int)(lds0+LDS_V)+((lane>>4)&1)*32+(lane&3)*8+(4*hi+((lane&15)>>2))*64;
  const char*Kbase=shm+LDS_K; bf16x8 kf[8];
  const lds_cptr shm3=(lds_cptr)shm; const lds_cptr kp0=shm3+LDS_K+hi*1024+r32*16; const lds_cptr vp0=shm3+LDS_V+((lane>>4)&1)*32+(lane&3)*8+(4*hi+((lane&15)>>2))*64;
  const int NT=S/KVBLK;
  DMA_K(0,0);DMA_V(0,0);DMA_K(1,SLOTB);
  bf16x8 qr[4];
  #pragma unroll
  for(int d0=0;d0<4;++d0)qr[d0]=*reinterpret_cast<const bf16x8*>(&Qw[(long)r32*DM+d0*16+hi*8]);
  float mhat=0.f,l_reg=0.f;f32x16 o[2];o[0]=f32x16{};o[1]=f32x16{};f32x16 negm=f32x16{};asm volatile("":"+v"(negm));
  #define CMASK(P0,P1,t) do{}while(0)
  bool resc=false;
  #define START(P0,P1) do{ const float rm=rowmax(P0,P1); resc=false; \
    { const float dl=rm; mhat=fadd_s(mhat,dl); \
      _Pragma("unroll") for(int r=0;r<16;++r){P0[r]=fsub_s(P0[r],dl);P1[r]=fsub_s(P1[r],dl);} \
      _Pragma("unroll") for(int r=0;r<16;++r)negm[r]=-mhat; asm volatile("":"+v"(negm)); } \
    _Pragma("unroll") for(int r=0;r<16;++r)P0[r]=__builtin_amdgcn_exp2f(P0[r]); }while(0)
  #define RESC() do{ if(resc){ asm volatile("s_waitcnt lgkmcnt(0)":::"memory"); \
      _Pragma("unroll") for(int d_=0;d_<2;++d_) _Pragma("unroll") for(int r=0;r<16;++r)o[d_][r]*=wsf[crow(r,hi)]; } }while(0)
  f32x16 pA0,pA1,pB0,pB1;
  int sl_prev=0,sl_cur=0,sl_next=SLOTB;
  #define ROT() do{sl_prev=sl_cur;sl_cur=sl_next;sl_next=(sl_next==(NSLOT-1)*SLOTB)?0:sl_next+SLOTB;}while(0)
  DMA_K(2,2*SLOTB);
  WAIT_BAR(3);
  qkt(pA0,pA1,Kbase,qr,negm,r32,hi);asm volatile("s_nop 15\n\ts_nop 7":"+v"(pA0),"+v"(pA1));CMASK(pA0,pA1,0);
  START(pA0,pA1);
  _Pragma("unroll") for(int r=0;r<16;++r)pA1[r]=__builtin_amdgcn_exp2f(pA1[r]);
  WAIT_BAR(0);
  DMA_K(3,0);DMA_V(1,SLOTB);
  ROT();
  kload8(kf,kp0+sl_cur);
  WAIT_BAR(2);
  s16x4 vlo[8],vhi[8]; u32x4 pw0,pw1,pw2,pw3;
  #define PKW(P,B) cvtpk_s(P[B],P[B+1])
  #define PAF(k) __builtin_bit_cast(bf16x8,pw##k)
  #define VFR(i) (bf16x8){vlo[i][0],vlo[i][1],vlo[i][2],vlo[i][3],vhi[i][0],vhi[i][1],vhi[i][2],vhi[i][3]}
  #define PIN(x) asm volatile("":"+v"(x))
  #define MX3(a,b,c) __builtin_fmaxf(__builtin_fmaxf((a),(b)),(c))
  #define GAPA(MF,A0,A1,A2,A3,W0,W1,PW) do{ MF; sacc+=A0; sacc+=A1; sacc+=A2; sacc+=A3; PIN(sacc); W0; W1; PIN(PW); SBAR(); }while(0)
  #define EX(v) __builtin_amdgcn_exp2f(v)
  #define GAPB(MF,X,B) do{ MF; X[B]=EX(X[B]); X[B+1]=EX(X[B+1]); X[B+2]=EX(X[B+2]); X[B+3]=EX(X[B+3]); PIN(X); SBAR(); }while(0)
  #define VRD(i) do{ vlo[i]=vtr(vp_+(((i)>>2)*4096+((i)&3)*1024)); vhi[i]=vtr(vp_+(((i)>>2)*4096+((i)&3)*1024+512)); }while(0)
  #define KRD(G,j) do{ if(G){ kload2(kf,kp0+sl_next,j); SBAR(); } }while(0)
  #define STEP(C0,C1,P0,P1,t,GK,GV,GL) do{ SBAR(); \
    const lds_cptr vp_=vp0+sl_prev; \
    VRD(0); SBAR(); float sacc=(P0[0]+P0[1]); \
    GAPA(C0=__builtin_amdgcn_mfma_f32_32x32x16_bf16(kf[0],qr[0],negm,0,0,0), P0[2],P0[3],P0[4],P0[5],     pw0[0]=PKW(P0,0), pw0[1]=PKW(P0,2), pw0); \
    VRD(4); SBAR(); GAPA(C1=__builtin_amdgcn_mfma_f32_32x32x16_bf16(kf[1],qr[0],negm,0,0,0), P0[6],P0[7],P0[8],P0[9],     pw0[2]=PKW(P0,4), pw0[3]=PKW(P0,6), pw0); \
    VRD(1); SBAR(); GAPA(C0=__builtin_amdgcn_mfma_f32_32x32x16_bf16(kf[2],qr[1],C0,0,0,0),   P0[10],P0[11],P0[12],P0[13], pw1[0]=PKW(P0,8), pw1[1]=PKW(P0,10), pw1); \
    VRD(5); SBAR(); GAPA(C1=__builtin_amdgcn_mfma_f32_32x32x16_bf16(kf[3],qr[1],C1,0,0,0),   P0[14],P0[15],P1[0],P1[1],   pw1[2]=PKW(P0,12),pw1[3]=PKW(P0,14), pw1); \
    VRD(2); SBAR(); GAPA(C0=__builtin_amdgcn_mfma_f32_32x32x16_bf16(kf[4],qr[2],C0,0,0,0),   P1[2],P1[3],P1[4],P1[5],     pw2[0]=PKW(P1,0), pw2[1]=PKW(P1,2), pw2); \
    VRD(6); SBAR(); GAPA(C1=__builtin_amdgcn_mfma_f32_32x32x16_bf16(kf[5],qr[2],C1,0,0,0),   P1[6],P1[7],P1[8],P1[9],     pw2[2]=PKW(P1,4), pw2[3]=PKW(P1,6), pw2); \
    VRD(3); SBAR(); GAPA(C0=__builtin_amdgcn_mfma_f32_32x32x16_bf16(kf[6],qr[3],C0,0,0,0),   P1[10],P1[11],P1[12],P1[13], pw3[0]=PKW(P1,8), pw3[1]=PKW(P1,10), pw3); \
    VRD(7); SBAR(); GAPA(C1=__builtin_amdgcn_mfma_f32_32x32x16_bf16(kf[7],qr[3],C1,0,0,0),   P1[14],P1[15],0.f,0.f,       pw3[2]=PKW(P1,12),pw3[3]=PKW(P1,14), pw3); \
    l_reg+=sacc; \
    if(GK){DMA_K((t)+3,sl_cur);} if(GV){DMA_V((t)+1,sl_next);} \
    CMASK(C0,C1,t); \
    { float a=MX3(C0[0],C0[1],C1[0]),b=MX3(C0[2],C0[3],C1[1]); a=MX3(a,C1[2],C1[3]); \
      _Pragma("unroll") for(int r=4;r<16;r+=4){a=MX3(a,C0[r],C0[r+1]);b=MX3(b,C0[r+2],C0[r+3]);a=MX3(a,C1[r],C1[r+1]);b=MX3(b,C1[r+2],C1[r+3]);} \
      float rm=__builtin_fmaxf(a,b); { auto rr=__builtin_amdgcn_permlane32_swap(__float_as_uint(rm),__float_as_uint(rm),false,false); rm=__builtin_fmaxf(__uint_as_float(rr[0]),__uint_as_float(rr[1])); } \
      resc=false; \
      if(__builtin_expect(__any(rm>(float)THRL),0)){ const float dl=__builtin_fmaxf(rm,0.f); mhat+=dl; \
        _Pragma("unroll") for(int r=0;r<16;++r){C0[r]-=dl;C1[r]-=dl;} \
        _Pragma("unroll") for(int r=0;r<16;++r)negm[r]=-mhat; asm volatile("":"+v"(negm)); \
        const float f=__builtin_amdgcn_exp2f(-dl); l_reg*=f; if(hi==0)wsf[r32]=f; resc=true; } } \
    SBAR(); \
    GAPB(o[0]=__builtin_amdgcn_mfma_f32_32x32x16_bf16(PAF(0),VFR(0),o[0],0,0,0), C0,0); \
    GAPB(o[1]=__builtin_amdgcn_mfma_f32_32x32x16_bf16(PAF(0),VFR(4),o[1],0,0,0), C0,4); \
    KRD(GL,0); GAPB(o[0]=__builtin_amdgcn_mfma_f32_32x32x16_bf16(PAF(1),VFR(1),o[0],0,0,0), C0,8); \
    KRD(GL,1); GAPB(o[1]=__builtin_amdgcn_mfma_f32_32x32x16_bf16(PAF(1),VFR(5),o[1],0,0,0), C0,12); \
    KRD(GL,2); GAPB(o[0]=__builtin_amdgcn_mfma_f32_32x32x16_bf16(PAF(2),VFR(2),o[0],0,0,0), C1,0); \
    KRD(GL,3); GAPB(o[1]=__builtin_amdgcn_mfma_f32_32x32x16_bf16(PAF(2),VFR(6),o[1],0,0,0), C1,4); \
    GAPB(o[0]=__builtin_amdgcn_mfma_f32_32x32x16_bf16(PAF(3),VFR(3),o[0],0,0,0), C1,8); \
    GAPB(o[1]=__builtin_amdgcn_mfma_f32_32x32x16_bf16(PAF(3),VFR(7),o[1],0,0,0), C1,12); \
    }while(0)
  int t=1;
  #undef CMASK
  #define CMASK(P0,P1,t) do{}while(0)
  for(;t+5<NT;t+=2){
    STEP(pB0,pB1,pA0,pA1,t,true,true,true);     WAIT_BAR(2); RESC(); ROT();
    STEP(pA0,pA1,pB0,pB1,t+1,true,true,true);   WAIT_BAR(2); RESC(); ROT();
  }
  #undef CMASK
  #define CMASK(P0,P1,t) do{}while(0)
  #define ENDW(tt) do{ if((tt)+3<NT){WAIT_BAR(2);} else if((tt)+2<NT){WAIT_BAR(1);} else {WAIT_BAR(0);} }while(0)
  for(;t+1<NT;t+=2){
    STEP(pB0,pB1,pA0,pA1,t,(t+3<NT),(t+1<NT),(t+1<NT));       ENDW(t);   RESC(); ROT();
    STEP(pA0,pA1,pB0,pB1,t+1,(t+4<NT),(t+2<NT),(t+2<NT));     ENDW(t+1); RESC(); ROT();
  }
  STEP(pB0,pB1,pA0,pA1,NT-1,false,false,false); RESC();
  { float sacc=pB0[0]+pB0[1]; _Pragma("unroll") for(int r=2;r<16;++r)sacc+=pB0[r]; _Pragma("unroll") for(int r=0;r<16;++r)sacc+=pB1[r]; l_reg+=sacc;
    pw0=(u32x4){PKW(pB0,0),PKW(pB0,2),PKW(pB0,4),PKW(pB0,6)};pw1=(u32x4){PKW(pB0,8),PKW(pB0,10),PKW(pB0,12),PKW(pB0,14)};pw2=(u32x4){PKW(pB1,0),PKW(pB1,2),PKW(pB1,4),PKW(pB1,6)};pw3=(u32x4){PKW(pB1,8),PKW(pB1,10),PKW(pB1,12),PKW(pB1,14)};
    SBAR(); pv(o,vb0+sl_cur,PAF(0),PAF(1),PAF(2),PAF(3)); }
  #undef PKW
  #undef PAF
  #undef VFR
  #undef PIN
  #undef MX3
  #undef GAPA
  #undef GAPB
  #undef EX
  #undef VRD
  #undef KRD
  #undef STEP
  #undef ENDW
  {auto rr=__builtin_amdgcn_permlane32_swap(__float_as_uint(l_reg),__float_as_uint(l_reg),false,false);l_reg=__uint_as_float(rr[0])+__uint_as_float(rr[1]);}
  if(hi==0)wsf[32+r32]=l_reg;asm volatile("s_waitcnt lgkmcnt(0)":::"memory");
  float rli[16];
  #pragma unroll
  for(int r=0;r<16;++r)rli[r]=__builtin_amdgcn_rcpf(wsf[32+crow(r,hi)]);
  bf16*Ow=Qw;
  { bf16*stg=(bf16*)(shm+LDS_OST)+wid*2048;
    #pragma unroll
    for(int r=0;r<16;++r){const int orow=crow(r,hi);
      #pragma unroll
      for(int d0=0;d0<2;++d0)stg[orow*64+d0*32+r32]=__float2bfloat16(o[d0][r]*rli[r]);}
    asm volatile("s_waitcnt lgkmcnt(0)":::"memory");
    #pragma unroll
    for(int i=0;i<4;++i){const int row=i*8+(lane>>3),ch=lane&7; const u32x4 v=*(const u32x4*)(stg+row*64+ch*8);
      const u32x4 z=*(const u32x4*)(Ow+(long)row*DM+512+ch*8);
      u32x4 w; float sq=0.f;
      #pragma unroll
      for(int k=0;k<4;++k){ const float o0=__uint_as_float(v[k]<<16),o1=__uint_as_float(v[k]&0xffff0000u),z0=__uint_as_float(z[k]<<16),z1=__uint_as_float(z[k]&0xffff0000u);
        const float y0=o0*z0*__builtin_amdgcn_rcpf(1.f+__expf(-z0)),y1=o1*z1*__builtin_amdgcn_rcpf(1.f+__expf(-z1)); const unsigned pk=cvtpk_s(y0,y1); w[k]=pk;
        const float r0=__uint_as_float(pk<<16),r1=__uint_as_float(pk&0xffff0000u); sq+=r0*r0+r1*r1; }
      ATTN_STORE16(Ow+(long)row*DM+ch*8,w);
      sq+=__shfl_xor(sq,1);sq+=__shfl_xor(sq,2);sq+=__shfl_xor(sq,4);
      if(ch==0)ssq[(rowbase+q0+wid*QBLK+row)*16+6+h]=sq; } }
  asm volatile("s_waitcnt lgkmcnt(0)\n\ts_barrier":::"memory");
  #undef DMA_K
  #undef DMA_V
  #undef CMASK
  #undef START
  #undef RESC
  #undef ROT
}
#undef SBAR
#undef WAIT_BAR
}
namespace wa {
typedef unsigned short bf16_t;
using bf16x8 = __attribute__((ext_vector_type(8))) short;
using s16x4 = __attribute__((ext_vector_type(4))) short;
using f32x16 = __attribute__((ext_vector_type(16))) float;
using u32x4 = __attribute__((ext_vector_type(4))) unsigned;
using u32x2 = __attribute__((ext_vector_type(2))) unsigned;
typedef __attribute__((address_space(3))) const char* lds_cptr;
typedef __attribute__((address_space(3))) char* lds_ptr;
typedef short v4i16_t __attribute__((ext_vector_type(4)));
constexpr int INW = 3840;
__device__ __forceinline__ int crow(int r, int hi) { return (r & 3) + 8 * (r >> 2) + 4 * hi; }
__device__ __forceinline__ s16x4 vtr(lds_cptr p) { return __builtin_bit_cast(s16x4, __builtin_amdgcn_ds_read_tr16_b64_v4i16((__attribute__((address_space(3))) v4i16_t*)p)); }
typedef float f32x2_t __attribute__((ext_vector_type(2))); typedef __bf16 bf16x2_t __attribute__((ext_vector_type(2)));
__device__ __forceinline__ unsigned cvtpk(float lo, float hi) { f32x2_t v = {lo, hi}; bf16x2_t b = __builtin_convertvector(v, bf16x2_t); return __builtin_bit_cast(unsigned, b); }
__device__ __forceinline__ float xhalf_max(float m) { auto rr = __builtin_amdgcn_permlane32_swap(__float_as_uint(m), __float_as_uint(m), false, false); return fmaxf(__uint_as_float(rr[0]), __uint_as_float(rr[1])); }
__device__ __forceinline__ float xhalf_sum(float m) { auto rr = __builtin_amdgcn_permlane32_swap(__float_as_uint(m), __float_as_uint(m), false, false); return __uint_as_float(rr[0]) + __uint_as_float(rr[1]); }
__device__ __forceinline__ float bflo(unsigned w) { return __uint_as_float(w << 16); }
__device__ __forceinline__ float bfhi(unsigned w) { return __uint_as_float(w & 0xffff0000u); }
__device__ __forceinline__ float silu(float z) { return z * __builtin_amdgcn_rcpf(1.f + __expf(-z)); }

struct St { f32x16 o0, o1; float m, l; };
__device__ __forceinline__ void st_init(St& s) { s.o0 = f32x16{}; s.o1 = f32x16{}; s.m = -1e30f; s.l = 0.f; }

template <int MODE>
__device__ __forceinline__ void tile(St& st, const bf16x8 (&qr)[4], lds_cptr kt, lds_cptr vt, int lane, int clo, const __attribute__((address_space(3))) float* bl) {
    const int r32 = lane & 31, hi = lane >> 5;
    f32x16 s = f32x16{};
    { const lds_cptr kp = kt + hi * 512 + r32 * 16;
#pragma unroll
      for (int d0 = 0; d0 < 4; ++d0) { const bf16x8 kf = *(const __attribute__((address_space(3))) bf16x8*)(kp + d0 * 1024); s = __builtin_amdgcn_mfma_f32_32x32x16_bf16(kf, qr[d0], s, 0, 0, 0); } }
    float tm = -INFINITY;
#pragma unroll
    for (int r = 0; r < 16; ++r) { const int a = (r & 3) + 8 * (r >> 2) + 4 * hi;
        if (MODE == 1) { if (a < r32) s[r] = -INFINITY; }
        if (MODE == 2) { if (a > r32) s[r] = -INFINITY; }
        if (MODE == 3) { const float b = bl[(r & 3) + 8 * (r >> 2)]; s[r] = ((unsigned)(a - clo) < 16u) ? s[r] + b : -INFINITY; }
        tm = fmaxf(tm, s[r]); }
    tm = xhalf_max(tm);
    const float mn = fmaxf(st.m, tm), alpha = __builtin_amdgcn_exp2f(st.m - mn); st.m = mn;
    float ps = 0.f;
#pragma unroll
    for (int r = 0; r < 16; ++r) { s[r] = __builtin_amdgcn_exp2f(s[r] - mn); ps += s[r]; }
    st.l = st.l * alpha + ps;
    st.o0 *= alpha; st.o1 *= alpha;
    u32x4 pw0, pw1;
    pw0[0] = cvtpk(s[0], s[1]); pw0[1] = cvtpk(s[2], s[3]); pw0[2] = cvtpk(s[4], s[5]); pw0[3] = cvtpk(s[6], s[7]);
    pw1[0] = cvtpk(s[8], s[9]); pw1[1] = cvtpk(s[10], s[11]); pw1[2] = cvtpk(s[12], s[13]); pw1[3] = cvtpk(s[14], s[15]);
    const lds_cptr vp = vt + ((lane >> 4) & 1) * 32 + (lane & 3) * 8 + (4 * hi + ((lane & 15) >> 2)) * 64;
#define WA_VF(ks, d0) ({ const s16x4 lo_ = vtr(vp + (d0) * 2048 + (ks) * 1024), hi_ = vtr(vp + (d0) * 2048 + (ks) * 1024 + 512); (bf16x8){lo_[0], lo_[1], lo_[2], lo_[3], hi_[0], hi_[1], hi_[2], hi_[3]}; })
    st.o0 = __builtin_amdgcn_mfma_f32_32x32x16_bf16(WA_VF(0, 0), __builtin_bit_cast(bf16x8, pw0), st.o0, 0, 0, 0);
    st.o1 = __builtin_amdgcn_mfma_f32_32x32x16_bf16(WA_VF(0, 1), __builtin_bit_cast(bf16x8, pw0), st.o1, 0, 0, 0);
    st.o0 = __builtin_amdgcn_mfma_f32_32x32x16_bf16(WA_VF(1, 0), __builtin_bit_cast(bf16x8, pw1), st.o0, 0, 0, 0);
    st.o1 = __builtin_amdgcn_mfma_f32_32x32x16_bf16(WA_VF(1, 1), __builtin_bit_cast(bf16x8, pw1), st.o1, 0, 0, 0);
#undef WA_VF
}

__device__ __forceinline__ void put_kv(lds_ptr ring, int voff, int slot, int rr, int c, u32x4 k, u32x4 v) {
    *(__attribute__((address_space(3))) u32x4*)(ring + slot * 4096 + c * 512 + rr * 16) = k;
    *(__attribute__((address_space(3))) u32x4*)(ring + voff + slot * 4096 + (c >> 2) * 2048 + rr * 64 + (c & 3) * 16) = v;
}

constexpr int A_VOFF = 49152;
__device__ __forceinline__ void a_unit(long base, int S, int h, int pat, int u, bf16_t* proj, bf16_t* OP, float* LSE, float* ssq, lds_ptr ring) {
    const int tid = tidx(), lane = tid & 63, r32 = lane & 31, hi = lane >> 5; const int wid = __builtin_amdgcn_readfirstlane(tid >> 6);
    const int dsh = 2 * pat, dil = 1 << dsh, L = S >> dsh;
    const bool two = (L == 128);
    const int nblk = two ? 1 : (L >> 8);
    const int rho0 = two ? 2 * u : u / nblk, j0 = two ? 0 : 256 * (u % nblk);
    const int SPS = two ? 4 : 12, ktlo = two ? 2 : 0, nslot = two ? 8 : 12;
    { const bf16_t* kb = proj + 384 + h * 64; const bf16_t* vb = proj + 768 + h * 64;
      for (int i0 = 0; i0 < nslot * 256; i0 += 512 * 3) {
          u32x4 kk[3], vv[3]; int ok[3];
#pragma unroll
          for (int i = 0; i < 3; ++i) { const int idx = i0 + i * 512 + tid; const int rowi = idx >> 3, c = idx & 7, slot = rowi >> 5, rr = rowi & 31, seg = slot / SPS, kt = slot % SPS + ktlo;
              const int j = j0 - 64 + 32 * kt + rr; ok[i] = (idx < nslot * 256) && j >= 0 && j < L;
              if (ok[i]) { const size_t g = (size_t)(base + (long)j * dil + rho0 + seg) * INW + c * 8; kk[i] = *(const u32x4*)(kb + g); vv[i] = *(const u32x4*)(vb + g); } }
#pragma unroll
          for (int i = 0; i < 3; ++i) { const int idx = i0 + i * 512 + tid; const int rowi = idx >> 3, c = idx & 7, slot = rowi >> 5, rr = rowi & 31; if (ok[i]) put_kv(ring, A_VOFF, slot, rr, c, kk[i], vv[i]); }
      } }
    __syncthreads();
    const int wps = two ? 4 : 8, seg = wid / wps, qi = wid % wps;
    const int jq = j0 + 32 * qi + r32; const long qrow = base + (long)jq * dil + rho0 + seg;
    bf16_t* qp = proj + (size_t)qrow * INW + h * 64;
    bf16x8 qr[4];
#pragma unroll
    for (int d0 = 0; d0 < 4; ++d0) qr[d0] = *(const bf16x8*)(qp + d0 * 16 + hi * 8);
    St st; st_init(st);
#pragma unroll
    for (int dk = 0; dk < 5; ++dk) { const int kt = qi + dk, jt = j0 - 64 + 32 * kt; if (jt < 0 || jt >= L) continue;
        const int slot = seg * SPS + kt - ktlo; const lds_cptr ktp = (lds_cptr)ring + slot * 4096, vtp = (lds_cptr)ring + A_VOFF + slot * 4096;
        if (dk == 0) tile<1>(st, qr, ktp, vtp, lane, 0, nullptr); else if (dk == 4) tile<2>(st, qr, ktp, vtp, lane, 0, nullptr); else tile<0>(st, qr, ktp, vtp, lane, 0, nullptr); }
    const float lt = xhalf_sum(st.l), il = __builtin_amdgcn_rcpf(lt), lse = st.m + __builtin_amdgcn_logf(lt);
    if (pat < 2) {
        bf16_t* op = OP + ((size_t)pat * 49152 + qrow) * 384 + h * 64 + 4 * hi;
#pragma unroll
        for (int g = 0; g < 4; ++g) { u32x2 w0, w1; w0[0] = cvtpk(st.o0[4 * g] * il, st.o0[4 * g + 1] * il); w0[1] = cvtpk(st.o0[4 * g + 2] * il, st.o0[4 * g + 3] * il);
            w1[0] = cvtpk(st.o1[4 * g] * il, st.o1[4 * g + 1] * il); w1[1] = cvtpk(st.o1[4 * g + 2] * il, st.o1[4 * g + 3] * il);
            *(u32x2*)(op + 8 * g) = w0; *(u32x2*)(op + 32 + 8 * g) = w1; }
        if (hi == 0) LSE[((size_t)pat * 49152 + qrow) * 8 + h] = lse;
    } else {
        const float l0 = LSE[((size_t)0 * 49152 + qrow) * 8 + h], l1 = LSE[((size_t)1 * 49152 + qrow) * 8 + h];
        const float M = fmaxf(fmaxf(l0, l1), lse); const float e0 = __builtin_amdgcn_exp2f(l0 - M), e1 = __builtin_amdgcn_exp2f(l1 - M), e2 = __builtin_amdgcn_exp2f(lse - M);
        const float inv = __builtin_amdgcn_rcpf(e0 + e1 + e2), w0 = e0 * inv, w1 = e1 * inv, w2 = e2 * inv * il;
        const bf16_t* op0 = OP + ((size_t)0 * 49152 + qrow) * 384 + h * 64 + 4 * hi; const bf16_t* op1 = OP + ((size_t)1 * 49152 + qrow) * 384 + h * 64 + 4 * hi;
        const bf16_t* zp = qp + 1152 + 4 * hi; bf16_t* yp = qp + 4 * hi; float sq = 0.f;
#pragma unroll
        for (int half = 0; half < 2; ++half)
#pragma unroll
            for (int g = 0; g < 4; ++g) { const int off = 32 * half + 8 * g; const u32x2 a = *(const u32x2*)(op0 + off), b = *(const u32x2*)(op1 + off), z = *(const u32x2*)(zp + off);
                const f32x16& oo = half ? st.o1 : st.o0; u32x2 y;
#pragma unroll
                for (int k = 0; k < 2; ++k) { const float y0 = (w0 * bflo(a[k]) + w1 * bflo(b[k]) + w2 * oo[4 * g + 2 * k]) * silu(bflo(z[k])), y1 = (w0 * bfhi(a[k]) + w1 * bfhi(b[k]) + w2 * oo[4 * g + 2 * k + 1]) * silu(bfhi(z[k]));
                    const unsigned pk = cvtpk(y0, y1); y[k] = pk; const float r0 = bflo(pk), r1 = bfhi(pk); sq += r0 * r0 + r1 * r1; }
                *(u32x2*)(yp + off) = y; }
        sq = xhalf_sum(sq);
        if (hi == 0) ssq[(size_t)qrow * 16 + h] = sq;
    }
    __syncthreads();
}

constexpr int C_BIAS_OFF = 65536;
__device__ __forceinline__ void c_unit(long base, int S, int h, int gr0, bf16_t* proj, const float* relb, float* ssq, lds_ptr ring) {
    const int tid = tidx(), lane = tid & 63, r32 = lane & 31, hi = lane >> 5; const int wid = __builtin_amdgcn_readfirstlane(tid >> 6);
    const int R = S >> 6;
    __attribute__((address_space(3))) float* bias = (__attribute__((address_space(3))) float*)(ring + C_BIAS_OFF) + 64;
    if (tid < 465) bias[tid] = relb[h * 465 + tid] * 1.4426950408889634f;
    const int gr = gr0 + (wid >> 1), qc = 32 * (wid & 1) + r32;
    int rs = gr - 4; rs = rs < 0 ? 0 : (rs > R - 8 ? R - 8 : rs);
    int cs = qc - 8; cs = cs < 0 ? 0 : (cs > 48 ? 48 : cs);
    int klo = gr0 - 4; klo = klo < 0 ? 0 : (klo > R - 8 ? R - 8 : klo);
    int khi = gr0 + 3 - 4; khi = khi < 0 ? 0 : (khi > R - 8 ? R - 8 : khi); khi += 8;
    const long qrow = base + gr * 64 + qc;
    bf16_t* qp = proj + (size_t)qrow * INW + 2304 + h * 64;
    bf16x8 qr[4];
#pragma unroll
    for (int d0 = 0; d0 < 4; ++d0) qr[d0] = *(const bf16x8*)(qp + d0 * 16 + hi * 8);
    St st; st_init(st);
    const bf16_t* kb = proj + 2688 + h * 64; const bf16_t* vb = proj + 3072 + h * 64;
    const int skc = tid >> 3, sc = tid & 7;
    u32x4 kk, vv;
    { const size_t g = (size_t)(base + klo * 64 + skc) * INW + sc * 8; kk = *(const u32x4*)(kb + g); vv = *(const u32x4*)(vb + g); }
    { lds_ptr bp = ring; *(__attribute__((address_space(3))) u32x4*)(bp + (skc >> 5) * 4096 + sc * 512 + (skc & 31) * 16) = kk;
      *(__attribute__((address_space(3))) u32x4*)(bp + 8192 + (skc >> 5) * 4096 + (sc >> 2) * 2048 + (skc & 31) * 64 + (sc & 3) * 16) = vv; }
    __syncthreads();
    int cur = 0;
    for (int kr = klo; kr < khi; ++kr) {
        const bool more = kr + 1 < khi;
        if (more) { const size_t g = (size_t)(base + (kr + 1) * 64 + skc) * INW + sc * 8; kk = *(const u32x4*)(kb + g); vv = *(const u32x4*)(vb + g); }
        if (kr >= rs && kr < rs + 8) {
            const __attribute__((address_space(3))) float* brow = bias + (kr - gr + 7) * 31 + 15 - qc + 4 * hi;
            const lds_cptr bp = (lds_cptr)ring + cur * 16384;
            tile<3>(st, qr, bp, bp + 8192, lane, cs, brow);
            tile<3>(st, qr, bp + 4096, bp + 8192 + 4096, lane, cs - 32, brow + 32);
        }
        if (more) { lds_ptr bp = ring + (cur ^ 1) * 16384; *(__attribute__((address_space(3))) u32x4*)(bp + (skc >> 5) * 4096 + sc * 512 + (skc & 31) * 16) = kk;
            *(__attribute__((address_space(3))) u32x4*)(bp + 8192 + (skc >> 5) * 4096 + (sc >> 2) * 2048 + (skc & 31) * 64 + (sc & 3) * 16) = vv; }
        __syncthreads(); cur ^= 1;
    }
    const float lt = xhalf_sum(st.l), il = __builtin_amdgcn_rcpf(lt);
    const bf16_t* zp = qp + 1152 + 4 * hi; bf16_t* yp = qp + 4 * hi; float sq = 0.f;
#pragma unroll
    for (int half = 0; half < 2; ++half)
#pragma unroll
        for (int g = 0; g < 4; ++g) { const int off = 32 * half + 8 * g; const u32x2 z = *(const u32x2*)(zp + off); const f32x16& oo = half ? st.o1 : st.o0; u32x2 y;
#pragma unroll
            for (int k = 0; k < 2; ++k) { const float y0 = oo[4 * g + 2 * k] * il * silu(bflo(z[k])), y1 = oo[4 * g + 2 * k + 1] * il * silu(bfhi(z[k]));
                const unsigned pk = cvtpk(y0, y1); y[k] = pk; const float r0 = bflo(pk), r1 = bfhi(pk); sq += r0 * r0 + r1 * r1; }
            *(u32x2*)(yp + off) = y; }
    sq = xhalf_sum(sq);
    if (hi == 0) ssq[(size_t)qrow * 16 + 10 + h] = sq;
    __syncthreads();
}
}
constexpr int NWAVES = 8;
constexpr int NTOK = 49152, NPROW = 16384, DMODEL = 1024, INW = 3840;
constexpr size_t MiB = 1u << 20;
constexpr size_t WS_CTL = 0, CTL_ZERO_BYTES = 64 * 1024;
constexpr size_t WS_WIN = 1 * MiB;
constexpr size_t WS_WOUT = 16 * MiB;
constexpr size_t WS_TABA = 20 * MiB, WS_TABR = WS_TABA + 8192 * 16 * 4, WS_TABC = WS_TABR + 128 * 32 * 4;
constexpr size_t WS_RPRE = 21 * MiB;
constexpr size_t WS_SSQ = 22 * MiB, WS_SSQ2 = 26 * MiB;
constexpr size_t WS_LSE = 30 * MiB;
constexpr size_t WS_PROJ = 34 * MiB;
constexpr size_t WS_U = WS_PROJ + (size_t)NTOK * INW * 2;
constexpr size_t WS_END = WS_U + (size_t)NTOK * DMODEL * 2;
static_assert((size_t)2 * NTOK * 384 * 2 <= (size_t)NTOK * DMODEL * 2, "OP fits in U");
constexpr int RING_BYTES = 131072, LDSCTL_OFF = RING_BYTES + 8192, MISC_OFF = LDSCTL_OFF + 320, LDS_BYTES = 147456;

#define GAS __attribute__((address_space(1)))
#define LAS __attribute__((address_space(3)))
typedef unsigned short bf16;
typedef unsigned v4u __attribute__((ext_vector_type(4)));
typedef float f32x4 __attribute__((ext_vector_type(4)));
typedef GAS unsigned gu32;
#define LDS_WAIT() asm volatile("s_waitcnt lgkmcnt(0)" ::: "memory")
__device__ __forceinline__ unsigned f2bf(float f) { unsigned u = __builtin_bit_cast(unsigned, f); return (u + 0x7fffu + ((u >> 16) & 1u)) >> 16; }
__device__ __forceinline__ unsigned pk2(float lo, float hi) { return f2bf(lo) | (f2bf(hi) << 16); }

#define XB_TMO      128
#define XB_XCNT(j)  (256  + 64 * (j))
#define XB_XSUB(j)  (1280 + 64 * (j))
#define XB_XGEN(j)  (2304 + 64 * (j))
#define XB_TOP      3328
#define XB_TOPGEN   3392
#define XCD_BAR_WORDS 3456
#define XB_SPIN_CAP (1u << 22)
__device__ __forceinline__ unsigned xb_ld(unsigned* p)              { return __hip_atomic_load(p, __ATOMIC_RELAXED, __HIP_MEMORY_SCOPE_AGENT); }
__device__ __forceinline__ unsigned xb_add(unsigned* p, unsigned v) { return __hip_atomic_fetch_add(p, v, __ATOMIC_RELAXED, __HIP_MEMORY_SCOPE_AGENT); }
__device__ __forceinline__ unsigned xb_xcc_id() { return (unsigned)__builtin_amdgcn_s_getreg((3 << 11) | 20) & 0xFu; }
#define XB_SPIN(cond, bar) do { unsigned _sp = 0; while (cond) { __builtin_amdgcn_s_sleep(1); \
    if ((++_sp & 255u) == 0u) { if (xb_ld(&(bar)[XB_TMO])) break; if (_sp > XB_SPIN_CAP) { atomicAdd(&(bar)[XB_TMO], 1u); break; } } } } while (0)
struct XcdBarrier { unsigned* bar; unsigned x; volatile LAS unsigned* st; };
__device__ __forceinline__ XcdBarrier xcd_barrier_post(unsigned* bar, volatile LAS unsigned* st) {
    XcdBarrier b; b.bar = bar; b.x = xb_xcc_id(); b.st = st;
    if (threadIdx.x == 0) (void)xb_add(&bar[XB_XCNT(b.x)], 1u);
    return b;
}
__device__ __forceinline__ void xcd_barrier_complete(unsigned* bar, unsigned x, unsigned& nloc, unsigned& nx) {
    const unsigned G = gridDim.x * gridDim.y * gridDim.z;
    unsigned sum, cnt, mine, sp = 0u;
    for (;;) {
        sum = 0u; cnt = 0u; mine = 0u;
#pragma unroll
        for (unsigned j = 0; j < 16; ++j) { const unsigned c = xb_ld(&bar[XB_XCNT(j)]); sum += c; cnt += (c > 0u) ? 1u : 0u; mine = (j == x) ? c : mine; }
        if (sum == G) break;
        __builtin_amdgcn_s_sleep(1);
        if ((++sp & 255u) == 0u) { if (xb_ld(&bar[XB_TMO])) break; if (sp > XB_SPIN_CAP) { atomicAdd(&bar[XB_TMO], 1u); break; } }
    }
    nloc = mine > 0u ? mine : 1u; nx = cnt > 0u ? cnt : 1u;
}
__device__ __forceinline__ void xcd_barrier(const XcdBarrier& b) {
    asm volatile("s_waitcnt vmcnt(0)" ::: "memory");
    __syncthreads();
    if (threadIdx.x == 0) {
        unsigned* bar = b.bar;
        __builtin_amdgcn_s_waitcnt(0);
        unsigned nloc = b.st[0], nx = b.st[1];
        if (nloc == 0u) { xcd_barrier_complete(bar, b.x, nloc, nx); b.st[0] = nloc; b.st[1] = nx; }
        const unsigned old = xb_add(&bar[XB_XSUB(b.x)], 1u);
        const unsigned gen = old / nloc;
        if (old + 1u == (gen + 1u) * nloc) {
            __builtin_amdgcn_fence(__ATOMIC_RELEASE, "agent");
            asm volatile("s_waitcnt vmcnt(0)" ::: "memory");
            const unsigned og = xb_add(&bar[XB_TOP], 1u);
            const unsigned tg = og / nx;
            if (og + 1u == (tg + 1u) * nx) xb_add(&bar[XB_TOPGEN], 1u);
            else XB_SPIN(xb_ld(&bar[XB_TOPGEN]) == tg, bar);
            __builtin_amdgcn_fence(__ATOMIC_ACQUIRE, "agent");
            xb_add(&bar[XB_XGEN(b.x)], 1u);
            asm volatile("s_waitcnt vmcnt(0)" ::: "memory");
        } else {
            XB_SPIN(xb_ld(&bar[XB_XGEN(b.x)]) == gen, bar);
            __builtin_amdgcn_fence(__ATOMIC_ACQUIRE, "agent");
            asm volatile("s_waitcnt vmcnt(0)" ::: "memory");
        }
    }
    __syncthreads();
}

__device__ __forceinline__ float wave_sum(float v) {
#pragma unroll
    for (int o = 1; o < 64; o <<= 1) v += __shfl_xor(v, o);
    return v;
}
__host__ __device__ __forceinline__ int phys2log(int n) { return (n & ~255) + 64 * ((n >> 5) & 3) + 32 * ((n >> 7) & 1) + (n & 31); }
template <bool PERMUTE>
__device__ __forceinline__ void p0_transpose_item(const float* W, const float* gain, int K, int N, bf16* WT, LAS float* scr, int item, int lane) {
    const int nblk = N / 32, kb = item / nblk, nb = item % nblk, k0 = 64 * kb, n0 = 32 * nb, l0 = PERMUTE ? phys2log(n0) : n0;
#pragma unroll 8
    for (int i = 0; i < 32; ++i) { const int kk = 2 * i + (lane >> 5); scr[kk * 33 + (lane & 31)] = W[(size_t)(k0 + kk) * N + l0 + (lane & 31)] * gain[k0 + kk]; }
    LDS_WAIT(); asm volatile("" ::: "memory");
    const int c = lane & 7;
#pragma unroll
    for (int j = 0; j < 4; ++j) { const int n = (lane >> 3) + 8 * j; const LAS float* s = scr + (8 * c) * 33 + n;
        v4u o; o.x = pk2(s[0 * 33], s[1 * 33]); o.y = pk2(s[2 * 33], s[3 * 33]); o.z = pk2(s[4 * 33], s[5 * 33]); o.w = pk2(s[6 * 33], s[7 * 33]);
        *(GAS v4u*)(WT + (size_t)(n0 + n) * K + k0 + 8 * c) = o; }
    LDS_WAIT(); asm volatile("" ::: "memory");
}
__device__ __forceinline__ void prep_row(const float* xrow, bf16* orow, float* rp, int lane) {
    const GAS f32x4* xr = (const GAS f32x4*)xrow + lane;
    f32x4 v[4]; float s = 0.f;
#pragma unroll
    for (int j = 0; j < 4; ++j) { v[j] = xr[64 * j]; s += (v[j].x * v[j].x + v[j].y * v[j].y) + (v[j].z * v[j].z + v[j].w * v[j].w); }
    s = wave_sum(s);
    if (lane == 0) *rp = rsqrtf(s * (1.f / 1024.f) + 1e-6f);
    GAS unsigned long long* o8 = (GAS unsigned long long*)orow + lane;
#pragma unroll
    for (int j = 0; j < 4; ++j) o8[64 * j] = (unsigned long long)pk2(v[j].x, v[j].y) | ((unsigned long long)pk2(v[j].z, v[j].w) << 32);
}
__device__ __forceinline__ void finish_row(const float* xrow, float* orow, bf16* urow, const float* s2, const float* gpost, float* rp, int lane) {
    const f32x4* s4 = (const f32x4*)s2; const f32x4 a = s4[0], b = s4[1], c = s4[2], d = s4[3];
    const float tot = ((a.x + a.y) + (a.z + a.w)) + ((b.x + b.y) + (b.z + b.w)) + ((c.x + c.y) + (c.z + c.w)) + ((d.x + d.y) + (d.z + d.w));
    const float r = rsqrtf(tot * (1.f / 1024.f) + 1e-6f);
    const GAS f32x4* xr = (const GAS f32x4*)xrow + lane; const GAS f32x4* gr = (const GAS f32x4*)gpost + lane; GAS f32x4* orr = (GAS f32x4*)orow + lane;
    GAS unsigned long long* u8 = (GAS unsigned long long*)urow + lane;
    float s = 0.f;
#pragma unroll
    for (int j = 0; j < 4; ++j) { const f32x4 x = xr[64 * j], g = gr[64 * j]; const unsigned long long w = u8[64 * j]; const unsigned w0 = (unsigned)w, w1 = (unsigned)(w >> 32);
        f32x4 n; n.x = x.x + __uint_as_float(w0 << 16) * r * g.x; n.y = x.y + __uint_as_float(w0 & 0xffff0000u) * r * g.y; n.z = x.z + __uint_as_float(w1 << 16) * r * g.z; n.w = x.w + __uint_as_float(w1 & 0xffff0000u) * r * g.w;
        orr[64 * j] = n; s += (n.x * n.x + n.y * n.y) + (n.z * n.z + n.w * n.w);
        u8[64 * j] = (unsigned long long)pk2(n.x, n.y) | ((unsigned long long)pk2(n.z, n.w) << 32); }
    s = wave_sum(s);
    if (lane == 0) *rp = rsqrtf(s * (1.f / 1024.f) + 1e-6f);
}

#ifdef NO_G1
#define RUN_G1(...)
#else
#define RUN_G1(...) __VA_ARGS__
#endif
#ifdef NO_G2
#define RUN_G2(...)
#else
#define RUN_G2(...) __VA_ARGS__
#endif
#ifdef NO_B
#define RUN_B(...)
#else
#define RUN_B(...) __VA_ARGS__
#endif
#ifdef NO_A
#define RUN_A(...)
#else
#define RUN_A(...) __VA_ARGS__
#endif
#ifdef NO_C
#define RUN_C(...)
#else
#define RUN_C(...) __VA_ARGS__
#endif
#ifdef NO_TAB
#define RUN_TAB 0
#else
#define RUN_TAB 1
#endif
struct Args { const float* in[10]; float* out; unsigned char* ws; int ph_lo, ph_hi, amask, pad; };
constexpr int N_PHASES = 11;
__global__ void __launch_bounds__(NWAVES * 64, 2) mk_fwd(Args args) {
    extern __shared__ __attribute__((aligned(16))) unsigned char lds[];
    LAS unsigned char* L = (LAS unsigned char*)lds;
    const int G = gridDim.x; const int bx = blockIdx.x; const int vcu = (G % 8 == 0) ? (bx % 8) * (G / 8) + bx / 8 : bx;
    for (int u = threadIdx.x; u < (LDS_BYTES - LDSCTL_OFF) / 4; u += NWAVES * 64) ((LAS unsigned*)(L + LDSCTL_OFF))[u] = 0u;
    __syncthreads();
    volatile LAS unsigned* MISC = (volatile LAS unsigned*)(L + MISC_OFF);
    XcdBarrier bar = xcd_barrier_post((unsigned*)(args.ws + WS_CTL), MISC + 8);
    const int lo = args.ph_lo, hi = args.ph_hi;
    for (int ph = lo; ph < hi; ++ph) {
        const int tid = tidx(), lane = tid & 63, wave = __builtin_amdgcn_readfirstlane(tid >> 6);
        const int gw = vcu * NWAVES + wave, NGW = G * NWAVES;
        unsigned char* ws = opaque_s(args.ws);
        const float* xp = args.in[0]; const float* xs = args.in[1]; const float* norm_pre = args.in[2]; const float* w_in = args.in[3]; const float* q_norm = args.in[4]; const float* k_norm = args.in[5];
        const float* rel_bias = args.in[6]; const float* branch_gain = args.in[7]; const float* w_out = args.in[8]; const float* norm_post = args.in[9];
        bf16* WIN = (bf16*)(ws + WS_WIN); bf16* WOUT = (bf16*)(ws + WS_WOUT); float* tabA = (float*)(ws + WS_TABA); float* tabR = (float*)(ws + WS_TABR); float* tabC = (float*)(ws + WS_TABC);
        float* rpre = (float*)(ws + WS_RPRE); float* ssq = (float*)(ws + WS_SSQ); float* ssq2 = (float*)(ws + WS_SSQ2); float* LSE = (float*)(ws + WS_LSE);
        bf16* proj = (bf16*)(ws + WS_PROJ); bf16* U = (bf16*)(ws + WS_U);
        if (ph == 0) {
            LAS float* scr = (LAS float*)(L + wave * 16384);
            constexpr int I_IN = 16 * 120, I_OUT = 16 * 32;
            for (int it = gw; it < 2 * (I_IN + I_OUT); it += NGW) { int r = it; const int l = r / (I_IN + I_OUT); r -= l * (I_IN + I_OUT);
                if (r < I_IN) p0_transpose_item<true>(w_in + (size_t)l * 1024 * 3840, norm_pre + l * 1024, 1024, 3840, WIN + (size_t)l * 3840 * 1024, scr, r, lane);
                else p0_transpose_item<false>(w_out + (size_t)l * 1024 * 1024, branch_gain + l * 1024, 1024, 1024, WOUT + (size_t)l * 1024 * 1024, scr, r - I_IN, lane); }
            { const int i = bx * (NWAVES * 64) + tid;
              if (RUN_TAB && i < 8192 * 8) { const int t = i >> 3, j = i & 7; const float a = (float)t * exp2f(-(float)j * (18.931568569324174f / 8.0f)); tabA[t * 16 + j] = cosf(a); tabA[t * 16 + 8 + j] = sinf(a); }
              if (RUN_TAB && i < 128 * 16) { const int t = i >> 4, j = i & 15; const float a = (float)t * exp2f(-(float)j * (13.287712379549449f / 16.0f)); const float c = cosf(a), sn = sinf(a); tabR[t * 32 + j] = c; tabR[t * 32 + 16 + j] = sn;
                  if (t < 64) { tabC[t * 32 + j] = c; tabC[t * 32 + 16 + j] = sn; } } }
            for (int m = gw; m < NTOK; m += NGW) prep_row(m < NPROW ? xp + (size_t)m * 1024 : xs + (size_t)(m - NPROW) * 1024, U + (size_t)m * 1024, rpre + m, lane);
        } else {
            const int l = (ph - 1) / 5, sub = (ph - 1) % 5;
            if (sub == 0) {
                pg8::Gemm g{U, WIN + (size_t)l * 3840 * 1024, NTOK, 3840, 1024, 1024}; pg8::StaticOrder S; S.init(NTOK, 3840, G, bx);
                pg8::EpiProj E{proj, rpre, q_norm + l * 64, k_norm + l * 64, tabA, tabR, tabC};
                RUN_G1(pg8::gemm_phase<pg8::EpiProj, pg8::StaticOrder, pg8::AMapLin, true, true>(L, g, S, E));
            } else if (sub == 1) {
                if (args.amask & 1) { const int x = vcu >> 5, s = vcu & 31;
                  RUN_B(attn_body::attn_unit<8>((long)(x >> 2) * 8192, 8192, 2 * ((x >> 1) & 1) + (x & 1), s, (attn_body::bf16*)proj, ssq, (char*)lds));
                  for (int j = 0; j < 2; ++j) { const int uid = 2 * s + j, seq = 2 * x + (uid >> 5), rest = uid & 31;
                      RUN_B(attn_body::attn_unit<8>((long)NPROW + (long)seq * 2048, 2048, rest >> 3, rest & 7, (attn_body::bf16*)proj, ssq, (char*)lds)); } }
                if (args.amask & 2) for (int it = vcu; it < 1152; it += G) { long base; int S_, h, gr0;
                    if (it < 384) { const int sq = it / 192, r = it % 192; base = (long)sq * 8192; S_ = 8192; h = r / 32; gr0 = 4 * (r % 32); }
                    else { const int i2 = it - 384, sq = i2 / 48, r = i2 % 48; base = (long)NPROW + (long)sq * 2048; S_ = 2048; h = r / 8; gr0 = 4 * (r % 8); }
                    RUN_C(wa::c_unit(base, S_, h, gr0, proj, rel_bias + (size_t)l * 6 * 465, ssq, (wa::lds_ptr)L)); }
                if (args.amask & 4) for (int it = vcu; it < 2304; it += G) { long base; int S_, h, pat, u;
                    if (it < 768) { const int sq = it / 384, r = it % 384; base = (long)sq * 8192; S_ = 8192; h = r / 64; pat = (r % 64) / 32; u = r % 32; }
                    else { const int i2 = it - 768, sq = i2 / 96, r = i2 % 96; base = (long)NPROW + (long)sq * 2048; S_ = 2048; h = r / 16; pat = (r % 16) / 8; u = r % 8; }
                    RUN_A(wa::a_unit(base, S_, h, pat, u, proj, U, LSE, ssq, (wa::lds_ptr)L)); }
            } else if (sub == 2) {
                if (args.amask & 4) for (int it = vcu; it < 1152; it += G) { long base; int S_, h, u;
                    if (it < 384) { const int sq = it / 192, r = it % 192; base = (long)sq * 8192; S_ = 8192; h = r / 32; u = r % 32; }
                    else { const int i2 = it - 384, sq = i2 / 48, r = i2 % 48; base = (long)NPROW + (long)sq * 2048; S_ = 2048; h = r / 8; u = r % 8; }
                    RUN_A(wa::a_unit(base, S_, h, 2, u, proj, U, LSE, ssq, (wa::lds_ptr)L)); }
            } else if (sub == 3) {
                pg8::Gemm g{proj, WOUT + (size_t)l * 1024 * 1024, NTOK, 1024, 1024, 3840}; pg8::StaticOrder S; S.init(NTOK, 1024, G, bx);
                pg8::EpiRaw E{U, ssq2, ssq};
                RUN_G2(pg8::gemm_phase<pg8::EpiRaw, pg8::StaticOrder, pg8::AMapY, true, true>(L, g, S, E));
            } else {
                for (int m = gw; m < NTOK; m += NGW) { const float* xrow = l == 0 ? (m < NPROW ? xp + (size_t)m * 1024 : xs + (size_t)(m - NPROW) * 1024) : args.out + (size_t)m * 1024;
                    finish_row(xrow, args.out + (size_t)m * 1024, U + (size_t)m * 1024, ssq2 + (size_t)m * 16, norm_post + l * 1024, rpre + m, lane); }
            }
        }
        if (ph + 1 < hi) xcd_barrier(bar);
    }
}

#ifndef MIX
#define MIX 0
#endif
static void launch_mk(Args a, int lo, int hi, hipStream_t stream) { a.ph_lo = lo; a.ph_hi = hi; hipLaunchKernelGGL(mk_fwd, dim3(256), dim3(NWAVES * 64), LDS_BYTES, stream, a); }
extern "C" void kernel_launch(void* const* d_in, const int* in_sizes, int n_in, void* d_out, int out_size, void* d_ws, size_t ws_size, hipStream_t stream) {
    static int ready = 0;
    if (ready == 0) {
        ready = -1;
        if (n_in != 10 || out_size != NTOK * DMODEL || ws_size < WS_END) { fprintf(stderr, "kernel_launch: unexpected shapes / workspace (%zu < %zu)\n", ws_size, (size_t)WS_END); return; }
        int dev = 0, cus = 0;
        if (hipGetDevice(&dev) != hipSuccess || hipDeviceGetAttribute(&cus, hipDeviceAttributeMultiprocessorCount, dev) != hipSuccess) return;
        if (cus != 256) { fprintf(stderr, "kernel_launch: built for 256 CUs, found %d\n", cus); return; }
        if (hipFuncSetAttribute((const void*)mk_fwd, hipFuncAttributeMaxDynamicSharedMemorySize, LDS_BYTES) != hipSuccess) return;
        int per_cu = 0; (void)hipOccupancyMaxActiveBlocksPerMultiprocessor(&per_cu, (const void*)mk_fwd, NWAVES * 64, LDS_BYTES); (void)hipGetLastError();
        if (per_cu < 1) fprintf(stderr, "kernel_launch: occupancy query reports %d blocks per CU\n", per_cu);
        ready = 1;
    }
    if (ready < 0) return;
    Args a{};
    for (int i = 0; i < 10; ++i) a.in[i] = (const float*)d_in[i];
    a.out = (float*)d_out; a.ws = (unsigned char*)d_ws; a.amask = 7;
    unsigned char* ws = (unsigned char*)d_ws;
#if MIX == 0
    (void)hipMemsetAsync(ws + WS_CTL, 0, CTL_ZERO_BYTES, stream);
    launch_mk(a, 0, N_PHASES, stream);
#else
    using nv::bf16_t; using nv::k_inproj; using nv::k_attnA; using nv::k_attnB; using nv::k_attnC; using nv::k_outproj; using nv::k_finish;
    bf16_t* proj = (bf16_t*)(ws + WS_PROJ); bf16_t* U = (bf16_t*)(ws + WS_U); float* ssq = (float*)(ws + WS_SSQ); float* ssq2 = (float*)(ws + WS_SSQ2); float* rpre = (float*)(ws + WS_RPRE);
    float* tabA = (float*)(ws + WS_TABA); float* tabR = (float*)(ws + WS_TABR); float* tabC = (float*)(ws + WS_TABC);
    const float* xp = a.in[0]; const float* xs = a.in[1];
    const float qs = (MIX & 1) ? 0.125f : 0.6931471805599453f;
    launch_mk(a, 0, 1, stream);
    for (int l = 0; l < 2; ++l) {
        if (MIX & 1) k_inproj<<<dim3(NTOK / 64, 60), 256, 0, stream>>>(U, rpre, a.in[3] + (size_t)l * 1024 * 3840, a.in[2] + l * 1024, a.in[4] + l * 64, a.in[5] + l * 64, tabA, tabR, tabC, proj);
        else launch_mk(a, 1 + 5 * l, 2 + 5 * l, stream);
        const int fastmask = ((MIX & 2) ? 0 : 1) | ((MIX & 4) ? 0 : 2) | ((MIX & 8) ? 0 : 4);
        if (fastmask) { Args b = a; b.amask = fastmask; launch_mk(b, 2 + 5 * l, 3 + 5 * l, stream); if (fastmask & 4) launch_mk(b, 3 + 5 * l, 4 + 5 * l, stream); }
        if (MIX & 2) k_attnB<<<dim3(192, 4), 256, 0, stream>>>(proj, ssq, qs);
        if (MIX & 8) k_attnA<<<dim3(NTOK / 256, 6), 256, 0, stream>>>(proj, ssq, qs);
        if (MIX & 4) k_attnC<<<dim3(NTOK / 256, 6), 256, 0, stream>>>(proj, a.in[6] + (size_t)l * 6 * 465, ssq, qs);
        if (MIX & 16) k_outproj<<<dim3(NTOK / 64, 16), 256, 0, stream>>>(proj, ssq, a.in[8] + (size_t)l * 1024 * 1024, a.in[7] + l * 1024, U, ssq2);
        else launch_mk(a, 4 + 5 * l, 5 + 5 * l, stream);
        if (MIX & 32) k_finish<<<NTOK, 256, 0, stream>>>(xp, xs, l, a.out, U, ssq2, a.in[9] + l * 1024, rpre);
        else launch_mk(a, 5 + 5 * l, 6 + 5 * l, stream);
    }
#endif
}
```
